# Optimizing an MI355X kernel written in HIP

```python
import math
import jax
import jax.numpy as jnp
from jax import lax
import numpy as np


D_MODEL = 1024
BATCH = 4
SEQ = 8192
DEPTH = 4

CTX_LEN = 256
GRID_W = 64

RWKV_HEADS = 8
RWKV_HEAD_DIM = 64
RWKV_W = RWKV_HEADS * RWKV_HEAD_DIM
DECAY_LORA = 64
ICLR_LORA = 64
GATE_LORA = 128
RWKV_COLS = 3 * RWKV_W + DECAY_LORA + ICLR_LORA + GATE_LORA
N_DIR = 2

DIFF_HEADS = 8
DIFF_HEAD_DIM = 32
DIFF_V_DIM = 2 * DIFF_HEAD_DIM
DIFF_QK = DIFF_HEADS * 2 * DIFF_HEAD_DIM
DIFF_W = DIFF_HEADS * DIFF_V_DIM
DIFF_COLS = 2 * DIFF_QK + DIFF_W

IN_COLS = RWKV_COLS + DIFF_COLS
MIX_W = RWKV_W + DIFF_W
D_FF = 4 * D_MODEL
Q_BLOCK = 128
ROPE_BASE = 10000.0
NORM_EPS = 1e-6
LNX_EPS = 64e-5
SUBLN_EPS = 1e-5

kernel_name = "hybrid_rwkv7_diffattn_dit"


def rms_norm(x, g, eps=NORM_EPS):
    x32 = x.astype(jnp.float32)
    y = x32 * lax.rsqrt(jnp.mean(x32 * x32, axis=-1, keepdims=True) + eps)
    return (y * g.astype(jnp.float32)).astype(x.dtype)


def modulate(h, shift, scale):
    return h * (1 + scale) + shift


def bi_token_shift(z, mu):
    zp = jnp.pad(z, ((0, 0), (1, 1), (0, 0)))
    return z + mu * (0.5 * (zp[:, :-2] + zp[:, 2:]) - z)


def rope_1d(x, pos):
    n = x.shape[-1] // 2
    inv_freq = ROPE_BASE ** (-jnp.arange(n, dtype=jnp.float32) / n)
    ang = pos.astype(jnp.float32)[:, None] * inv_freq[None, :]
    cos = jnp.cos(ang)[None, :, None, :]
    sin = jnp.sin(ang)[None, :, None, :]
    x1 = x[..., :n].astype(jnp.float32)
    x2 = x[..., n:].astype(jnp.float32)
    return jnp.concatenate([x1 * cos - x2 * sin, x1 * sin + x2 * cos], axis=-1).astype(x.dtype)


def axial_rope(x, rows, cols):
    half = x.shape[-1] // 2
    return jnp.concatenate([rope_1d(x[..., :half], rows), rope_1d(x[..., half:], cols)], axis=-1)


def diff_attend(q1, q2, k1, k2, v, lam):
    bsz, lq, nh, dh = q1.shape
    nb = lq // Q_BLOCK
    scale = dh ** -0.5

    def blocks(q):
        return q.reshape(bsz, nb, Q_BLOCK, nh, dh).transpose(1, 0, 2, 3, 4)

    def one_block(qs):
        a1, a2 = qs
        s1 = jnp.einsum("bqhd,bkhd->bhqk", a1, k1).astype(jnp.float32) * scale
        s2 = jnp.einsum("bqhd,bkhd->bhqk", a2, k2).astype(jnp.float32) * scale
        p = jax.nn.softmax(s1, axis=-1) - lam * jax.nn.softmax(s2, axis=-1)
        return jnp.einsum("bhqk,bkhd->bqhd", p.astype(v.dtype), v)

    o = lax.map(one_block, (blocks(q1), blocks(q2)))
    return o.transpose(1, 0, 2, 3, 4).reshape(bsz, lq, nh, v.shape[-1])


def wkv_scan(state0, r, w, k, v, kk, b, reverse):
    xs = tuple(jnp.swapaxes(t.astype(jnp.float32), 0, 1) for t in (r, w, k, v, kk, b))

    def step(state, inp):
        r_t, w_t, k_t, v_t, kk_t, b_t = inp
        sa = jnp.einsum("bhvk,bhk->bhv", state, kk_t)
        state = (state * w_t[:, :, None, :]
                 - sa[..., :, None] * b_t[:, :, None, :]
                 + v_t[..., :, None] * k_t[:, :, None, :])
        y = jnp.einsum("bhvk,bhk->bhv", state, r_t)
        return state, y

    state, ys = lax.scan(step, state0, xs, reverse=reverse)
    return state, jnp.swapaxes(ys, 0, 1)


def rwkv_inputs(z, k_k):
    bsz, t, _ = z.shape
    heads = lambda u: u.reshape(bsz, t, RWKV_HEADS, RWKV_HEAD_DIM)
    r = heads(z[..., :RWKV_W])
    k = heads(z[..., RWKV_W:2 * RWKV_W])
    v = heads(z[..., 2 * RWKV_W:3 * RWKV_W])
    o = 3 * RWKV_W
    xw = z[..., o:o + DECAY_LORA]
    xa = z[..., o + DECAY_LORA:o + DECAY_LORA + ICLR_LORA]
    xg = z[..., o + DECAY_LORA + ICLR_LORA:]
    kk = (k * k_k.reshape(RWKV_HEADS, RWKV_HEAD_DIM)).astype(jnp.float32)
    kk = kk / jnp.maximum(jnp.sqrt(jnp.sum(kk * kk, axis=-1, keepdims=True)), 1e-12)
    return r, k, v, kk, xw, xa, xg


def direction_terms(k, kk, xw, xa, w0, w_b, a0, a_b, k_a):
    shp = k.shape
    wl = (w0 + jnp.tanh(xw) @ w_b).astype(jnp.float32)
    decay = jnp.exp(-jnp.exp(-jax.nn.softplus(-wl) - 0.5)).reshape(shp)
    a = jax.nn.sigmoid((a0 + xa @ a_b).astype(jnp.float32)).reshape(shp)
    k_a32 = k_a.reshape(RWKV_HEADS, RWKV_HEAD_DIM).astype(jnp.float32)
    k_mod = k.astype(jnp.float32) * (1 + (a - 1) * k_a32)
    return decay, k_mod, kk * a


def rwkv_finish(y, r, k, v, xg, r_k, g_b, lnx_g, lnx_b, dtype):
    bsz, t = y.shape[:2]
    mu = jnp.mean(y, axis=-1, keepdims=True)
    var = jnp.mean(jnp.square(y - mu), axis=-1, keepdims=True)
    yn = ((y - mu) * lax.rsqrt(var + LNX_EPS)).reshape(bsz, t, RWKV_W)
    yn = yn * lnx_g.astype(jnp.float32) + lnx_b.astype(jnp.float32)
    r32, k32, v32 = (u.astype(jnp.float32) for u in (r, k, v))
    bonus = (jnp.sum(r32 * k32 * r_k.astype(jnp.float32), axis=-1, keepdims=True) * v32).reshape(bsz, t, RWKV_W)
    gate = (jax.nn.sigmoid(xg) @ g_b).astype(jnp.float32)
    return ((yn + bonus) * gate).astype(dtype)


def rwkv_group(z, zc, k_k, k_a, w0, w_b, a0, a_b, g_b, r_k, lnx_g, lnx_b, need_ctx):
    r, k, v, kk, xw, xa, xg = rwkv_inputs(z, k_k)
    rc, kc, vc, kkc, xwc, xac, xgc = rwkv_inputs(zc, k_k)
    state0 = jnp.zeros((z.shape[0], RWKV_HEADS, RWKV_HEAD_DIM, RWKV_HEAD_DIM), jnp.float32)
    y_lat = jnp.zeros(r.shape, jnp.float32)
    y_ctx = jnp.zeros(rc.shape, jnp.float32)
    for d, reverse in enumerate((False, True)):
        dec_c, km_c, b_c = direction_terms(kc, kkc, xwc, xac, w0[d], w_b[d], a0[d], a_b[d], k_a)
        dec, km, bb = direction_terms(k, kk, xw, xa, w0[d], w_b[d], a0[d], a_b[d], k_a)
        state_c, yc = wkv_scan(state0, rc, dec_c, km_c, vc, kkc, b_c, reverse)
        _, yl = wkv_scan(state_c, r, dec, km, v, kk, bb, reverse)
        y_lat = y_lat + yl
        y_ctx = y_ctx + yc
    out = rwkv_finish(y_lat, r, k, v, xg, r_k, g_b, lnx_g, lnx_b, z.dtype)
    out_c = rwkv_finish(y_ctx, rc, kc, vc, xgc, r_k, g_b, lnx_g, lnx_b, z.dtype) if need_ctx else None
    return out, out_c


def diff_split(t):
    bsz, n, _ = t.shape
    q = t[..., :DIFF_QK].reshape(bsz, n, DIFF_HEADS, 2, DIFF_HEAD_DIM)
    k = t[..., DIFF_QK:2 * DIFF_QK].reshape(bsz, n, DIFF_HEADS, 2, DIFF_HEAD_DIM)
    v = t[..., 2 * DIFF_QK:].reshape(bsz, n, DIFF_HEADS, DIFF_V_DIM)
    return q[..., 0, :], q[..., 1, :], k[..., 0, :], k[..., 1, :], v


def diff_group(z, zc, lam_q1, lam_k1, lam_q2, lam_k2, subln_g, lambda_init, rows, cols, need_ctx):
    q1, q2, k1, k2, v = diff_split(z)
    q1c, q2c, k1c, k2c, vc = diff_split(zc)
    q1, q2, k1, k2 = (axial_rope(u, rows, cols) for u in (q1, q2, k1, k2))
    lam = (jnp.exp(jnp.sum(lam_q1.astype(jnp.float32) * lam_k1.astype(jnp.float32)))
           - jnp.exp(jnp.sum(lam_q2.astype(jnp.float32) * lam_k2.astype(jnp.float32)))
           + lambda_init)
    kk1 = jnp.concatenate([k1, k1c], axis=1)
    kk2 = jnp.concatenate([k2, k2c], axis=1)
    vv = jnp.concatenate([v, vc], axis=1)
    bsz, n = z.shape[:2]
    o = diff_attend(q1, q2, kk1, kk2, vv, lam)
    out = (rms_norm(o, subln_g, SUBLN_EPS) * (1 - lambda_init)).reshape(bsz, n, DIFF_W)
    out_c = None
    if need_ctx:
        oc = diff_attend(q1c, q2c, k1c, k2c, vc, lam)
        out_c = (rms_norm(oc, subln_g, SUBLN_EPS) * (1 - lambda_init)).reshape(bsz, zc.shape[1], DIFF_W)
    return out, out_c


def sq_relu_mlp(h, w1, w2):
    return jnp.square(jax.nn.relu(h @ w1)) @ w2


def setup_inputs(seed: int = 0) -> dict:
    key = jax.random.key(seed)
    ks = jax.random.split(key, 32)
    f32 = jnp.float32
    D = D_MODEL
    nrm = lambda k, shape, s: jax.random.normal(k, shape, f32) * s
    return {
        "x": nrm(ks[0], (BATCH, SEQ, D), 1.0),
        "c": nrm(ks[1], (BATCH, D), 1.0),
        "ctx": nrm(ks[2], (BATCH, CTX_LEN, D), 1.0),
        "c_ctx": nrm(ks[3], (D,), 1.0),
        "ada_w": nrm(ks[4], (DEPTH, D, 6 * D), 0.5 * D ** -0.5),
        "ada_b": nrm(ks[5], (DEPTH, 6 * D), 0.02),
        "g_pre_mix": 1.0 + nrm(ks[6], (DEPTH, D), 0.02),
        "g_post_mix": 1.0 + nrm(ks[7], (DEPTH, D), 0.02),
        "g_pre_mlp": 1.0 + nrm(ks[8], (DEPTH, D), 0.02),
        "g_post_mlp": 1.0 + nrm(ks[9], (DEPTH, D), 0.02),
        "w_in": nrm(ks[10], (DEPTH, D, IN_COLS), D ** -0.5),
        "shift_mu": jax.random.uniform(ks[11], (DEPTH, RWKV_COLS), f32),
        "k_k": 0.85 + nrm(ks[12], (DEPTH, RWKV_W), 0.02),
        "k_a": 1.0 + nrm(ks[13], (DEPTH, RWKV_W), 0.02),
        "w0": jax.random.uniform(ks[14], (DEPTH, N_DIR, RWKV_W), f32, -3.0, 0.0),
        "w_b": nrm(ks[15], (DEPTH, N_DIR, DECAY_LORA, RWKV_W), 0.1),
        "a0": nrm(ks[16], (DEPTH, N_DIR, RWKV_W), 0.1),
        "a_b": nrm(ks[17], (DEPTH, N_DIR, ICLR_LORA, RWKV_W), 0.1),
        "g_b": nrm(ks[18], (DEPTH, GATE_LORA, RWKV_W), GATE_LORA ** -0.5),
        "r_k": nrm(ks[19], (DEPTH, RWKV_HEADS, RWKV_HEAD_DIM), 0.1),
        "lnx_g": 1.0 + nrm(ks[20], (DEPTH, RWKV_W), 0.02),
        "lnx_b": nrm(ks[21], (DEPTH, RWKV_W), 0.02),
        "lam_q1": nrm(ks[22], (DEPTH, DIFF_HEAD_DIM), 0.1),
        "lam_k1": nrm(ks[23], (DEPTH, DIFF_HEAD_DIM), 0.1),
        "lam_q2": nrm(ks[24], (DEPTH, DIFF_HEAD_DIM), 0.1),
        "lam_k2": nrm(ks[25], (DEPTH, DIFF_HEAD_DIM), 0.1),
        "subln_g": 1.0 + nrm(ks[26], (DEPTH, DIFF_V_DIM), 0.02),
        "w_out": nrm(ks[27], (DEPTH, MIX_W, D), MIX_W ** -0.5),
        "w_ff1": nrm(ks[28], (DEPTH, D, D_FF), D ** -0.5),
        "w_ff2": nrm(ks[29], (DEPTH, D_FF, D), D_FF ** -0.5),
    }


def reference(x, c, ctx, c_ctx, ada_w, ada_b, g_pre_mix, g_post_mix, g_pre_mlp, g_post_mlp,
              w_in, shift_mu, k_k, k_a, w0, w_b, a0, a_b, g_b, r_k, lnx_g, lnx_b,
              lam_q1, lam_k1, lam_q2, lam_k2, subln_g, w_out, w_ff1, w_ff2):
    n_tok = x.shape[1]
    n_rows = n_tok // GRID_W
    rows = jnp.repeat(jnp.arange(n_rows, dtype=jnp.int32), GRID_W)
    cols = jnp.tile(jnp.arange(GRID_W, dtype=jnp.int32), n_rows)
    sc = jax.nn.silu(c)
    scc = jax.nn.silu(c_ctx)
    xc = ctx
    for l in range(DEPTH):
        need_ctx = l < DEPTH - 1
        lambda_init = 0.8 - 0.6 * math.exp(-0.3 * l)
        mod = (sc @ ada_w[l] + ada_b[l])[:, None, :]
        modc = scc @ ada_w[l] + ada_b[l]
        sh1, s1, g1, sh2, s2, g2 = jnp.split(mod, 6, axis=-1)
        sh1c, s1c, g1c, sh2c, s2c, g2c = jnp.split(modc, 6, axis=-1)

        h = modulate(rms_norm(x, g_pre_mix[l]), sh1, s1)
        hc = modulate(rms_norm(xc, g_pre_mix[l]), sh1c, s1c)
        z = h @ w_in[l]
        zc = hc @ w_in[l]
        zr = bi_token_shift(z[..., :RWKV_COLS], shift_mu[l])
        zrc = bi_token_shift(zc[..., :RWKV_COLS], shift_mu[l])
        o_r, o_rc = rwkv_group(zr, zrc, k_k[l], k_a[l], w0[l], w_b[l], a0[l], a_b[l], g_b[l],
                               r_k[l], lnx_g[l], lnx_b[l], need_ctx)
        o_d, o_dc = diff_group(z[..., RWKV_COLS:], zc[..., RWKV_COLS:], lam_q1[l], lam_k1[l],
                               lam_q2[l], lam_k2[l], subln_g[l], lambda_init, rows, cols, need_ctx)
        o = jnp.concatenate([o_r, o_d], axis=-1) @ w_out[l]
        x = x + g1 * rms_norm(o, g_post_mix[l])
        if need_ctx:
            oc = jnp.concatenate([o_rc, o_dc], axis=-1) @ w_out[l]
            xc = xc + g1c * rms_norm(oc, g_post_mix[l])

        f = sq_relu_mlp(modulate(rms_norm(x, g_pre_mlp[l]), sh2, s2), w_ff1[l], w_ff2[l])
        x = x + g2 * rms_norm(f, g_post_mlp[l])
        if need_ctx:
            fc = sq_relu_mlp(modulate(rms_norm(xc, g_pre_mlp[l]), sh2c, s2c), w_ff1[l], w_ff2[l])
            xc = xc + g2c * rms_norm(fc, g_post_mlp[l])
    return x
```

```cpp
#include <hip/hip_runtime.h>
#include <hip/hip_cooperative_groups.h>
#include <cstdio>
#include <cstdint>
namespace cg = cooperative_groups;

#ifndef MULTI_LAUNCH
#define MULTI_LAUNCH 0
#endif

#define DEVI __device__ __forceinline__
#define LDS_AS __attribute__((address_space(3)))
typedef unsigned short bf16_t;
typedef _Float16 f16_t;
typedef short bf16x8 __attribute__((ext_vector_type(8)));
typedef float f32x16 __attribute__((ext_vector_type(16)));
typedef float f32x4 __attribute__((ext_vector_type(4)));
typedef unsigned u32x4 __attribute__((ext_vector_type(4)));
typedef unsigned u32x2 __attribute__((ext_vector_type(2)));
typedef _Float16 f16x4 __attribute__((ext_vector_type(4)));
typedef _Float16 f16x8 __attribute__((ext_vector_type(8)));

constexpr int DM = 1024, NB = 4, SEQ = 8192, DEPTH = 4, CTX = 256;
constexpr int TL = NB * SEQ, TC = NB * CTX, NT = TL + TC;
constexpr int RC = 1792, INC = 3328, DFF = 4096, NKEY = SEQ + CTX;
constexpr int NPH = 2 + DEPTH * 10;

constexpr size_t SZ_T512x2 = (size_t)NT * 512 * 2;
constexpr size_t OFF_QK = 0;
constexpr size_t OFF_VT = OFF_QK + 2 * SZ_T512x2;
constexpr size_t OFF_ZR = OFF_VT + SZ_T512x2;
constexpr size_t OFF_Y = OFF_ZR + 3 * SZ_T512x2;
constexpr size_t OFF_LA = OFF_Y;
constexpr size_t OFF_HID = 0;
constexpr size_t OFF_B = 8 * SZ_T512x2;
constexpr size_t OFF_GATE = OFF_B;
constexpr size_t OFF_EW = OFF_B + SZ_T512x2;
constexpr size_t OFF_AA = OFF_B + 3 * SZ_T512x2;
constexpr size_t OFF_F = OFF_B;
constexpr size_t OFF_ZA = OFF_B;
constexpr size_t SZ_W = (size_t)(1024 * 1024 + 2 * 1024 * 4096) * 2;
constexpr size_t OFF_W = OFF_B + 5 * SZ_T512x2 - SZ_W;
constexpr size_t OFF_H = OFF_B + 5 * SZ_T512x2;
constexpr size_t OFF_XC = OFF_H + 2 * SZ_T512x2;
constexpr size_t OFF_KN = OFF_XC + (size_t)TC * 1024 * 4;
constexpr size_t OFF_MOD = OFF_KN + (size_t)NT * 8 * 4;
constexpr size_t OFF_LW = OFF_MOD + (size_t)DEPTH * 5 * 6144 * 4;
constexpr size_t OFF_ROPE = OFF_LW + (size_t)DEPTH * 196608 * 2;
constexpr size_t OFF_CTR = OFF_ROPE + 128 * 8 * 8;
constexpr size_t OFF_KM = OFF_CTR + 256;
constexpr size_t OFF_BAR = OFF_KM + 256;
constexpr size_t WS_END = OFF_BAR + 3456 * 4;
static_assert((size_t)NT * 1024 * 4 <= 5 * SZ_T512x2 - SZ_W, "F overlaps W");
static_assert((size_t)NT * RC * 2 <= 5 * SZ_T512x2 - SZ_W, "ZA overlaps W");
static_assert(WS_END <= (size_t)536870912, "workspace too big");

struct Params {
  const float *x, *c, *ctx, *c_ctx, *ada_w, *ada_b, *g_pre_mix, *g_post_mix, *g_pre_mlp, *g_post_mlp,
      *w_in, *shift_mu, *k_k, *k_a, *w0, *w_b, *a0, *a_b, *g_b, *r_k, *lnx_g, *lnx_b,
      *lam_q1, *lam_k1, *lam_q2, *lam_k2, *subln_g, *w_out, *w_ff1, *w_ff2;
  float* out;
  unsigned char* ws;
};

DEVI unsigned pk_bf16(float lo, float hi) {
  unsigned r;
  asm("v_cvt_pk_bf16_f32 %0, %1, %2" : "=v"(r) : "v"(lo), "v"(hi));
  return r;
}
DEVI bf16_t f2bf(float f) { return (bf16_t)(pk_bf16(f, 0.f) & 0xffffu); }
DEVI float bflo(unsigned u) { return __uint_as_float(u << 16); }
DEVI float bfhi(unsigned u) { return __uint_as_float(u & 0xffff0000u); }
DEVI int get_tid() { int t = threadIdx.x; asm volatile("" : "+v"(t)); return t; }
DEVI float sigmoidf_(float x) { return __builtin_amdgcn_rcpf(1.0f + __expf(-x)); }
DEVI int lane_id_() { int l = (int)__builtin_amdgcn_mbcnt_hi(~0u, __builtin_amdgcn_mbcnt_lo(~0u, 0u)); asm volatile("" : "+v"(l)); return l; }
DEVI float shfl_xor_(float v, int o) { return __int_as_float(__builtin_amdgcn_ds_bpermute((lane_id_() ^ o) << 2, __float_as_int(v))); }
DEVI float wave_sum(float v) {
#pragma unroll
  for (int o = 32; o >= 1; o >>= 1) v += shfl_xor_(v, o);
  return v;
}
template <int CTRL> DEVI float dpp_add(float v) {
  int t = __builtin_amdgcn_update_dpp(0, __float_as_int(v), CTRL, 0xf, 0xf, true);
  return v + __int_as_float(t);
}
template <int CTRL> DEVI float dpp_get(float v) {
  return __int_as_float(__builtin_amdgcn_update_dpp(0, __float_as_int(v), CTRL, 0xf, 0xf, true));
}
DEVI float allreduce16(float v) {
  v = dpp_add<0xB1>(v);
  v = dpp_add<0x4E>(v);
  v = dpp_add<0x141>(v);
  v = dpp_add<0x140>(v);
  return v;
}
DEVI float* xrow(const Params& p, int row) {
  return row < TL ? p.out + (size_t)row * 1024 : (float*)(p.ws + OFF_XC) + (size_t)(row - TL) * 1024;
}
DEVI const float* xin_row(const Params& p, int row) {
  return row < TL ? p.x + (size_t)row * 1024 : p.ctx + (size_t)(row - TL) * 1024;
}
DEVI int mod_idx(int row) { return row < TL ? (row >> 13) : 4; }

DEVI void convert_tile(const float* __restrict__ src, int K, int N, bf16_t* __restrict__ dst, int tk, int tn,
                       unsigned char* smem) {
  float* tile = (float*)smem;
  const int tid = get_tid();
  {
    const int kr = tid >> 4, nc = (tid & 15) * 4;
#pragma unroll
    for (int i = 0; i < 4; ++i) {
      const int k = kr + i * 16;
      const f32x4 v = __builtin_nontemporal_load((const f32x4*)(src + (size_t)(tk * 64 + k) * N + tn * 64 + nc));
      tile[k * 65 + nc + 0] = v[0]; tile[k * 65 + nc + 1] = v[1];
      tile[k * 65 + nc + 2] = v[2]; tile[k * 65 + nc + 3] = v[3];
    }
  }
  __syncthreads();
  {
    const int n = tid >> 2, kc = (tid & 3) * 16;
    u32x4 o0, o1;
    o0[0] = pk_bf16(tile[(kc + 0) * 65 + n], tile[(kc + 1) * 65 + n]);
    o0[1] = pk_bf16(tile[(kc + 2) * 65 + n], tile[(kc + 3) * 65 + n]);
    o0[2] = pk_bf16(tile[(kc + 4) * 65 + n], tile[(kc + 5) * 65 + n]);
    o0[3] = pk_bf16(tile[(kc + 6) * 65 + n], tile[(kc + 7) * 65 + n]);
    o1[0] = pk_bf16(tile[(kc + 8) * 65 + n], tile[(kc + 9) * 65 + n]);
    o1[1] = pk_bf16(tile[(kc + 10) * 65 + n], tile[(kc + 11) * 65 + n]);
    o1[2] = pk_bf16(tile[(kc + 12) * 65 + n], tile[(kc + 13) * 65 + n]);
    o1[3] = pk_bf16(tile[(kc + 14) * 65 + n], tile[(kc + 15) * 65 + n]);
    bf16_t* d = dst + (size_t)(tn * 64 + n) * K + tk * 64 + kc;
    *(u32x4*)d = o0;
    *(u32x4*)(d + 8) = o1;
  }
  __syncthreads();
}
DEVI void convert_matrix(const float* src, int K, int N, bf16_t* dst, unsigned char* smem) {
  const int nk = K / 64, nn = N / 64;
  for (int t = blockIdx.x; t < nk * nn; t += gridDim.x) convert_tile(src, K, N, dst, t / nn, t % nn, smem);
}

enum { EPI_F32 = 0, EPI_BF16 = 1, EPI_RELU2 = 2, EPI_EW = 3, EPI_SIG = 4, EPI_F16 = 5, EPI_G1 = 6 };
struct GemmJob {
  const bf16_t* A; int lda;
  const bf16_t* Bt;
  int K, M, N, epi;
  void* out; int ldc;
  const float* bias;
};

template <int EPI> DEVI void gemm_tile(const Params& p, const GemmJob& g, int tm, int tn, unsigned char* smem) {
  const int tid = get_tid(), lane = tid & 63, wave = tid >> 6;
  const int wm = wave >> 1, wn = wave & 1, r32 = lane & 31, hh = lane >> 5;
  const int lrow = tid >> 3, lch = tid & 7;
  const bf16_t* Ag[4];
  const bf16_t* Bg[4];
#pragma unroll
  for (int i = 0; i < 4; ++i) {
    const int row = lrow + i * 32, c = lch ^ ((row >> 1) & 7);
    Ag[i] = g.A + (size_t)(tm * 128 + row) * g.lda + c * 8;
    Bg[i] = g.Bt + (size_t)(tn * 128 + row) * g.K + c * 8;
  }
  f32x16 acc[2][2];
#pragma unroll
  for (int i = 0; i < 2; ++i)
#pragma unroll
    for (int j = 0; j < 2; ++j)
#pragma unroll
      for (int e = 0; e < 16; ++e) acc[i][j][e] = 0.f;
  const int nk = g.K >> 6;
  unsigned char* lds_t = smem + tid * 16;
#define GEMM_STAGE(kt_, buf_)                                                                                   \
  {                                                                                                             \
    _Pragma("unroll") for (int i = 0; i < 4; ++i) {                                                             \
      __builtin_amdgcn_global_load_lds((const unsigned*)(Ag[i] + (kt_) * 64), (LDS_AS unsigned*)(lds_t + (buf_) * 32768 + i * 4096), 16, 0, 0);          \
      __builtin_amdgcn_global_load_lds((const unsigned*)(Bg[i] + (kt_) * 64), (LDS_AS unsigned*)(lds_t + (buf_) * 32768 + 16384 + i * 4096), 16, 0, 0);  \
    }                                                                                                           \
  }
  GEMM_STAGE(0, 0);
  asm volatile("s_waitcnt vmcnt(0)" ::: "memory");
  __syncthreads();
  int aoff[2], boff[2];
#pragma unroll
  for (int mi = 0; mi < 2; ++mi) { const int row = wm * 64 + mi * 32 + r32; aoff[mi] = row * 128; }
#pragma unroll
  for (int ni = 0; ni < 2; ++ni) { const int row = wn * 64 + ni * 32 + r32; boff[ni] = 16384 + row * 128; }
  const int sw = (r32 >> 1) & 7;
  for (int kt = 0; kt < nk; ++kt) {
    const bool more = (kt + 1 < nk);
    const unsigned char* base = smem + (kt & 1) * 32768;
    bf16x8 a[4][2], b[4][2];
#pragma unroll
    for (int ks = 0; ks < 4; ++ks) {
      const int co = ((ks * 2 + hh) ^ sw) << 4;
#pragma unroll
      for (int mi = 0; mi < 2; ++mi) a[ks][mi] = *(const bf16x8*)(base + aoff[mi] + co);
#pragma unroll
      for (int ni = 0; ni < 2; ++ni) b[ks][ni] = *(const bf16x8*)(base + boff[ni] + co);
    }
    __builtin_amdgcn_sched_barrier(0);
    if (more) GEMM_STAGE(kt + 1, (kt + 1) & 1);
    __builtin_amdgcn_sched_barrier(0);
#pragma unroll
    for (int ks = 0; ks < 4; ++ks)
#pragma unroll
      for (int mi = 0; mi < 2; ++mi)
#pragma unroll
        for (int ni = 0; ni < 2; ++ni)
          acc[mi][ni] = __builtin_amdgcn_mfma_f32_32x32x16_bf16(a[ks][mi], b[ks][ni], acc[mi][ni], 0, 0, 0);
    __builtin_amdgcn_sched_barrier(0);
    asm volatile("s_waitcnt vmcnt(0)" ::: "memory");
    __syncthreads();
  }
#undef GEMM_STAGE
  const int row_b = tm * 128 + wm * 64 + 4 * hh, col_b = tn * 128 + wn * 64 + r32;
  constexpr int epi = EPI;
  if (epi == EPI_G1 && tn >= 22) {
    bf16_t* VT = (bf16_t*)(p.ws + OFF_VT);
#pragma unroll
    for (int mi = 0; mi < 2; ++mi)
#pragma unroll
      for (int ni = 0; ni < 2; ++ni) {
        const int n2 = col_b + ni * 32 - 2816;
        const int head = n2 >> 6, dv = n2 & 63;
#pragma unroll
        for (int jq = 0; jq < 4; ++jq) {
          const int row = row_b + mi * 32 + 8 * jq;
          int b, key;
          if (row < TL) { b = row >> 13; key = row & 8191; } else { b = (row - TL) >> 8; key = 8192 + ((row - TL) & 255); }
          u32x2 w;
          w[0] = pk_bf16(acc[mi][ni][4 * jq + 0], acc[mi][ni][4 * jq + 1]);
          w[1] = pk_bf16(acc[mi][ni][4 * jq + 2], acc[mi][ni][4 * jq + 3]);
          *(u32x2*)(VT + (size_t)((b * 8 + head) * 64 + dv) * NKEY + key) = w;
        }
      }
    return;
  }
  float* ct = (float*)smem;
#pragma unroll
  for (int mi = 0; mi < 2; ++mi)
#pragma unroll
    for (int ni = 0; ni < 2; ++ni) {
      const int col_l = wn * 64 + ni * 32 + r32;
      float bias = 0.f;
      if (epi == EPI_EW || epi == EPI_SIG) bias = g.bias[tn * 128 + col_l];
#pragma unroll
      for (int j = 0; j < 16; ++j) {
        const int row_l = wm * 64 + mi * 32 + (j & 3) + 8 * (j >> 2) + 4 * hh;
        float v = acc[mi][ni][j];
        if (epi == EPI_RELU2) { v = fmaxf(v, 0.f); v = v * v; }
        else if (epi == EPI_EW) v = -0.8750612634f * sigmoidf_(v + bias);
        else if (epi == EPI_SIG) v = sigmoidf_(v + bias);
        ct[row_l * 128 + col_l] = v;
      }
    }
  __syncthreads();
  {
    unsigned short* outp; int ldc, col0;
    if (epi == EPI_G1) {
      if (tn < 14) { outp = (unsigned short*)(p.ws + OFF_ZA); ldc = RC; col0 = tn * 128; }
      else { outp = (unsigned short*)(p.ws + OFF_QK); ldc = 1024; col0 = tn * 128 - RC; }
    } else { outp = (unsigned short*)g.out; ldc = g.ldc; col0 = tn * 128; }
    constexpr bool F16OUT = (epi == EPI_EW || epi == EPI_SIG || epi == EPI_F16);
#pragma unroll
    for (int i = 0; i < 8; ++i) {
      const int q = tid + 256 * i, row_l = q >> 4, cc = (q & 15) * 8;
      const f32x4 v0 = *(const f32x4*)(ct + row_l * 128 + cc), v1 = *(const f32x4*)(ct + row_l * 128 + cc + 4);
      u32x4 w;
      if (F16OUT) {
        f16x8 h;
        h[0] = (f16_t)v0[0]; h[1] = (f16_t)v0[1]; h[2] = (f16_t)v0[2]; h[3] = (f16_t)v0[3];
        h[4] = (f16_t)v1[0]; h[5] = (f16_t)v1[1]; h[6] = (f16_t)v1[2]; h[7] = (f16_t)v1[3];
        w = __builtin_bit_cast(u32x4, h);
      } else {
        w[0] = pk_bf16(v0[0], v0[1]); w[1] = pk_bf16(v0[2], v0[3]); w[2] = pk_bf16(v1[0], v1[1]); w[3] = pk_bf16(v1[2], v1[3]);
      }
      __builtin_nontemporal_store(w, (u32x4*)(outp + (size_t)(tm * 128 + row_l) * ldc + col0 + cc));
    }
  }
  __syncthreads();
}
struct Place { int xcc, rank, swz, scanpref; };
template <int EPI> DEVI void gemm_run(const Params& p, const GemmJob& g, unsigned char* smem, const Place& pl) {
  const int nm = g.M >> 7, nn = g.N >> 7;
  if (pl.swz) {
    const int nsn = nn >> 3, nn8 = nsn << 3, nsm = (nm + 7) >> 3;
    const int lm = pl.rank >> 3, ln = pl.rank & 7;
    for (int sid = pl.xcc; sid < nsm * nsn; sid += 8) {
      const int sm = sid / nsn, sn = sid - sm * nsn;
      const int tm = sm * 8 + lm, tn = sn * 8 + ln;
      if (tm < nm) gemm_tile<EPI>(p, g, tm, tn, smem);
    }
    const int rem = nn - nn8;
    for (int t = blockIdx.x; t < nm * rem; t += gridDim.x) gemm_tile<EPI>(p, g, t / rem, nn8 + t % rem, smem);
  } else {
    for (int t = blockIdx.x; t < nm * nn; t += gridDim.x) gemm_tile<EPI>(p, g, t / nn, t % nn, smem);
  }
}

DEVI void modvec_item(const Params& p, int item, unsigned char* smem) {
  const int l = item / 96, chunk = item % 96, tid = get_tid();
  float* sc = (float*)smem;
  float* red = (float*)(smem + 20480);
  for (int i = tid; i < 5 * 1024; i += 256) {
    const int b = i >> 10, k = i & 1023;
    const float v = b < 4 ? p.c[b * 1024 + k] : p.c_ctx[k];
    sc[i] = v * sigmoidf_(v);
  }
  __syncthreads();
  const int col = tid & 63, kg = tid >> 6;
  const float* w = p.ada_w + (size_t)l * 1024 * 6144 + chunk * 64 + col;
  float a0 = 0, a1 = 0, a2 = 0, a3 = 0, a4 = 0;
#pragma unroll 8
  for (int k = kg * 256; k < kg * 256 + 256; ++k) {
    const float wv = __builtin_nontemporal_load(w + (size_t)k * 6144);
    a0 += sc[k] * wv; a1 += sc[1024 + k] * wv; a2 += sc[2048 + k] * wv; a3 += sc[3072 + k] * wv; a4 += sc[4096 + k] * wv;
  }
  red[(kg * 5 + 0) * 64 + col] = a0; red[(kg * 5 + 1) * 64 + col] = a1; red[(kg * 5 + 2) * 64 + col] = a2;
  red[(kg * 5 + 3) * 64 + col] = a3; red[(kg * 5 + 4) * 64 + col] = a4;
  __syncthreads();
  float* MOD = (float*)(p.ws + OFF_MOD);
  for (int i = tid; i < 5 * 64; i += 256) {
    const int b = i >> 6, cc = i & 63;
    const float s = red[(0 * 5 + b) * 64 + cc] + red[(1 * 5 + b) * 64 + cc] + red[(2 * 5 + b) * 64 + cc] + red[(3 * 5 + b) * 64 + cc];
    const int gc = chunk * 64 + cc;
    MOD[(size_t)(l * 5 + b) * 6144 + gc] = s + p.ada_b[l * 6144 + gc];
  }
  __syncthreads();
}

DEVI void phase_setup(const Params& p, unsigned char* smem) {
  const int tid = get_tid();
  if (blockIdx.x == 0) {
    if (tid < 64) ((int*)(p.ws + OFF_CTR))[tid] = 0;
  }
  if (blockIdx.x == (gridDim.x > 1 ? 1 : 0)) {
    float2* RT = (float2*)(p.ws + OFF_ROPE);
    for (int i = tid; i < 1024; i += 256) {
      const int pos = i >> 3, f = i & 7;
      const float invf[8] = {1.0f, 0.31622776601683794f, 0.1f, 0.03162277660168379f, 0.01f, 0.003162277660168379f, 0.001f, 0.00031622776601683794f};
      float fr = 1.0f;
#pragma unroll
      for (int q = 0; q < 8; ++q) if (f == q) fr = invf[q];
      const float ang = (float)pos * fr;
      const double rev = (double)ang * 0.15915494309189535;
      const float fx = (float)(rev - floor(rev));
      RT[i] = make_float2(__builtin_amdgcn_cosf(fx), __builtin_amdgcn_sinf(fx));
    }
  }
  for (int it = blockIdx.x; it < DEPTH * 96; it += gridDim.x) modvec_item(p, it, smem);
  for (int it = blockIdx.x; it < DEPTH * 48; it += gridDim.x) {
    const int l = it / 48, r = it % 48;
    bf16_t* LW = (bf16_t*)(p.ws + OFF_LW) + (size_t)l * 196608;
    if (r < 32) {
      const int m = r >> 3, t = r & 7;
      const float* src = (m < 2 ? p.w_b : p.a_b) + (size_t)(l * 2 + (m & 1)) * 64 * 512;
      convert_tile(src, 64, 512, LW + m * 32768, 0, t, smem);
    } else {
      const int t = r - 32;
      convert_tile(p.g_b + (size_t)l * 128 * 512, 128, 512, LW + 131072, t >> 3, t & 7, smem);
    }
  }
  convert_matrix(p.w_in, 1024, INC, (bf16_t*)(p.ws + OFF_W), smem);
}

DEVI void rowpass(const Params& p, int mode, int l) {
  const int tid = get_tid(), lane = tid & 63, wave = tid >> 6;
  const int nrows = (l == DEPTH - 1 && mode >= 1) ? TL : NT;
  const float* MOD = (const float*)(p.ws + OFF_MOD);
  const bool from_in = (mode == 0 || (mode == 1 && l == 0));
  const int stride = gridDim.x * 4;
  f32x4 xv[4], fv[4], nxv[4], nfv[4];
#define RP_LOAD(XV, FV, r_)                                                                        \
  { const float* xs_ = from_in ? xin_row(p, (r_)) : xrow(p, (r_));                                 \
    _Pragma("unroll") for (int j = 0; j < 4; ++j) XV[j] = __builtin_nontemporal_load((const f32x4*)(xs_ + j * 256 + lane * 4)); \
    if (mode != 0) { const bf16_t* F_ = (const bf16_t*)(p.ws + OFF_F) + (size_t)(r_) * 1024;        \
      _Pragma("unroll") for (int j = 0; j < 4; ++j) { const u32x2 w_ = __builtin_nontemporal_load((const u32x2*)(F_ + j * 256 + lane * 4)); \
        FV[j][0] = bflo(w_[0]); FV[j][1] = bfhi(w_[0]); FV[j][2] = bflo(w_[1]); FV[j][3] = bfhi(w_[1]); } } }
#pragma unroll
  for (int j = 0; j < 4; ++j) { fv[j] = (f32x4){0.f, 0.f, 0.f, 0.f}; nfv[j] = fv[j]; nxv[j] = fv[j]; xv[j] = fv[j]; }
  int row = blockIdx.x * 4 + wave;
  if (row < nrows) RP_LOAD(xv, fv, row);
  for (; row < nrows; row += stride) {
    const int mi = mod_idx(row);
    if (row + stride < nrows) RP_LOAD(nxv, nfv, row + stride);
    if (mode != 0) {
      float ss = 0.f;
#pragma unroll
      for (int j = 0; j < 4; ++j) ss += fv[j][0] * fv[j][0] + fv[j][1] * fv[j][1] + fv[j][2] * fv[j][2] + fv[j][3] * fv[j][3];
      ss = wave_sum(ss);
      const float rstd = rsqrtf(ss * (1.0f / 1024.0f) + 1e-6f);
      const float* gpost = (mode == 1 ? p.g_post_mix : p.g_post_mlp) + l * 1024;
      const float* gate = MOD + (size_t)((l * 5 + mi) * 6 + (mode == 1 ? 2 : 5)) * 1024;
      float* xd = xrow(p, row);
#pragma unroll
      for (int j = 0; j < 4; ++j) {
        const f32x4 gp = *(const f32x4*)(gpost + j * 256 + lane * 4);
        const f32x4 gt = *(const f32x4*)(gate + j * 256 + lane * 4);
        xv[j] = xv[j] + gt * (fv[j] * rstd * gp);
        __builtin_nontemporal_store(xv[j], (f32x4*)(xd + j * 256 + lane * 4));
      }
    }
    if (!(mode == 2 && l == DEPTH - 1)) {
      const int l2 = (mode == 2) ? l + 1 : l;
      const float* gpre = (mode == 1 ? p.g_pre_mlp : p.g_pre_mix) + l2 * 1024;
      const float* sh = MOD + (size_t)((l2 * 5 + mi) * 6 + (mode == 1 ? 3 : 0)) * 1024;
      const float* sc = sh + 1024;
      float ss = 0.f;
#pragma unroll
      for (int j = 0; j < 4; ++j) ss += xv[j][0] * xv[j][0] + xv[j][1] * xv[j][1] + xv[j][2] * xv[j][2] + xv[j][3] * xv[j][3];
      ss = wave_sum(ss);
      const float rstd = rsqrtf(ss * (1.0f / 1024.0f) + 1e-6f);
      bf16_t* H = (bf16_t*)(p.ws + OFF_H) + (size_t)row * 1024;
#pragma unroll
      for (int j = 0; j < 4; ++j) {
        const f32x4 gp = *(const f32x4*)(gpre + j * 256 + lane * 4);
        const f32x4 s1 = *(const f32x4*)(sc + j * 256 + lane * 4);
        const f32x4 s0 = *(const f32x4*)(sh + j * 256 + lane * 4);
        const f32x4 hv = (xv[j] * rstd * gp) * (1.0f + s1) + s0;
        u32x2 w;
        w[0] = pk_bf16(hv[0], hv[1]); w[1] = pk_bf16(hv[2], hv[3]);
        *(u32x2*)(H + j * 256 + lane * 4) = w;
      }
    }
#pragma unroll
    for (int j = 0; j < 4; ++j) { xv[j] = nxv[j]; fv[j] = nfv[j]; }
  }
#undef RP_LOAD
}

DEVI void p1_shift(const Params& p, int l) {
  const bf16_t* ZA = (const bf16_t*)(p.ws + OFF_ZA);
  bf16_t* ZR = (bf16_t*)(p.ws + OFF_ZR);
  bf16_t* LA = (bf16_t*)(p.ws + OFF_LA);
  float* KN = (float*)(p.ws + OFF_KN);
  const float* mu = p.shift_mu + l * RC;
  const float* kkw = p.k_k + l * 512;
  const int total = NT * 224;
  for (int idx = blockIdx.x * 256 + get_tid(); idx < total; idx += gridDim.x * 256) {
    const int row = idx / 224, ch = idx - row * 224, col = ch * 8;
    int pos, len;
    if (row < TL) { pos = row & 8191; len = 8192; } else { pos = (row - TL) & 255; len = 256; }
    const bf16_t* zp = ZA + (size_t)row * RC + col;
    const u32x4 zc = *(const u32x4*)zp;
    u32x4 zl = {0, 0, 0, 0}, zn = {0, 0, 0, 0};
    if (pos > 0) zl = *(const u32x4*)(zp - RC);
    if (pos < len - 1) zn = *(const u32x4*)(zp + RC);
    const f32x4 m0 = *(const f32x4*)(mu + col), m1 = *(const f32x4*)(mu + col + 4);
    float zs[8];
#pragma unroll
    for (int j = 0; j < 4; ++j) {
      const float c0 = bflo(zc[j]), c1 = bfhi(zc[j]);
      const float n0 = 0.5f * (bflo(zl[j]) + bflo(zn[j])), n1 = 0.5f * (bfhi(zl[j]) + bfhi(zn[j]));
      const float mu0 = (2 * j < 4) ? m0[2 * j] : m1[2 * j - 4];
      const float mu1 = (2 * j + 1 < 4) ? m0[2 * j + 1] : m1[2 * j + 1 - 4];
      zs[2 * j] = c0 + mu0 * (n0 - c0);
      zs[2 * j + 1] = c1 + mu1 * (n1 - c1);
    }
    float ksq = 0.f;
    const bool isk = (col >= 512 && col < 1024);
    if (col < 1536) {
      u32x4 o;
#pragma unroll
      for (int j = 0; j < 4; ++j) o[j] = pk_bf16(zs[2 * j], zs[2 * j + 1]);
      __builtin_nontemporal_store(o, (u32x4*)(ZR + (size_t)row * 1536 + col));
      if (isk) {
        const f32x4 k0 = *(const f32x4*)(kkw + col - 512), k1 = *(const f32x4*)(kkw + col - 512 + 4);
#pragma unroll
        for (int j = 0; j < 4; ++j) { const float a = zs[j] * k0[j], b = zs[4 + j] * k1[j]; ksq += a * a + b * b; }
      }
    } else {
      const int lc = col - 1536;
      float v[8];
#pragma unroll
      for (int j = 0; j < 8; ++j) {
        if (lc < 64) { const float e = __expf(2.0f * zs[j]); v[j] = 1.0f - 2.0f / (e + 1.0f); }
        else if (lc < 128) v[j] = zs[j];
        else v[j] = sigmoidf_(zs[j]);
      }
      u32x4 o;
#pragma unroll
      for (int j = 0; j < 4; ++j) o[j] = pk_bf16(v[2 * j], v[2 * j + 1]);
      __builtin_nontemporal_store(o, (u32x4*)(LA + (size_t)row * 256 + lc));
    }
    ksq += shfl_xor_(ksq, 1); ksq += shfl_xor_(ksq, 2); ksq += shfl_xor_(ksq, 4);
    if (isk && (ch & 7) == 0) KN[row * 8 + ((col - 512) >> 6)] = 1.0f / fmaxf(sqrtf(ksq), 1e-12f);
  }
}

DEVI void p1_rope(const Params& p) {
  bf16_t* QK = (bf16_t*)(p.ws + OFF_QK);
  const float2* RT = (const float2*)(p.ws + OFF_ROPE);
  const float qs = 0.17677669529663687f * 1.4426950408889634f;
  const int total = NT * 64;
  for (int idx = blockIdx.x * 256 + get_tid(); idx < total; idx += gridDim.x * 256) {
    const int row = idx >> 6, u = idx & 63, col = u * 16;
    const bool isq = col < 512;
    if (row >= TL && !isq) continue;
    bf16_t* ptr = QK + (size_t)row * 1024 + col;
    const u32x4 a = *(const u32x4*)ptr, b = *(const u32x4*)(ptr + 8);
    float x1[8], x2[8];
#pragma unroll
    for (int j = 0; j < 4; ++j) { x1[2 * j] = bflo(a[j]); x1[2 * j + 1] = bfhi(a[j]); x2[2 * j] = bflo(b[j]); x2[2 * j + 1] = bfhi(b[j]); }
    if (row < TL) {
      const int t = row & 8191;
      const int pos = (u & 1) ? (t & 63) : (t >> 6);
#pragma unroll
      for (int i = 0; i < 8; ++i) {
        const float2 cs = RT[pos * 8 + i];
        const float o1 = x1[i] * cs.x - x2[i] * cs.y, o2 = x1[i] * cs.y + x2[i] * cs.x;
        x1[i] = o1; x2[i] = o2;
      }
    }
    if (isq) {
#pragma unroll
      for (int i = 0; i < 8; ++i) { x1[i] *= qs; x2[i] *= qs; }
    }
    u32x4 oa, ob;
#pragma unroll
    for (int j = 0; j < 4; ++j) { oa[j] = pk_bf16(x1[2 * j], x1[2 * j + 1]); ob[j] = pk_bf16(x2[2 * j], x2[2 * j + 1]); }
    *(u32x4*)ptr = oa;
    *(u32x4*)(ptr + 8) = ob;
  }
}

typedef float f32x2 __attribute__((ext_vector_type(2)));
struct ScOp { f32x4 w, kk, nb, km, r; float v; };
DEVI void sc_ld(ScOp& o, const float* tb, const float* vp) {
  o.w = *(const f32x4*)tb; o.kk = *(const f32x4*)(tb + 64); o.nb = *(const f32x4*)(tb + 128);
  o.km = *(const f32x4*)(tb + 192); o.r = *(const f32x4*)(tb + 256); o.v = *vp;
}
constexpr int SC_TOK = 16, SC_STRIDE = 336;
struct ScRaw { u32x2 gr, gk, gv; f16x4 gew, ga; float gkn; };
DEVI void scan_item(const Params& p, int l, int item, unsigned char* smem) {
  const int tid = get_tid(), lane = tid & 63, wave = tid >> 6;
  const int rg = item & 3, dir = (item >> 2) & 1, h = (item >> 3) & 7, b = item >> 6;
  const int rl = lane >> 4, kl = lane & 15;
  float* IN = (float*)smem;
  float* YB = (float*)(smem + 2 * SC_TOK * SC_STRIDE * 4);
  const bf16_t* ZR = (const bf16_t*)(p.ws + OFF_ZR);
  const f16_t* EW = (const f16_t*)(p.ws + OFF_EW) + (size_t)dir * NT * 512;
  const f16_t* AA = (const f16_t*)(p.ws + OFF_AA) + (size_t)dir * NT * 512;
  const float* KN = (const float*)(p.ws + OFF_KN);
  f16_t* Y = (f16_t*)(p.ws + OFF_Y) + (size_t)dir * NT * 512;
  const int tl = tid >> 4, cg4 = (tid & 15) * 4;
  const f32x4 kkc = *(const f32x4*)(p.k_k + l * 512 + h * 64 + cg4);
  const f32x4 kac = *(const f32x4*)(p.k_a + l * 512 + h * 64 + cg4);
  ScRaw RA, RB;
  RA.gv[0] = 0; RA.gv[1] = 0; RB.gv[0] = 0; RB.gv[1] = 0;
#define SC_ROW(s, rowvar)                                                        \
  {                                                                              \
    int s_ = (s);                                                                \
    if (s_ < 256) rowvar = TL + b * 256 + (dir ? 255 - s_ : s_);                 \
    else { s_ -= 256; rowvar = b * 8192 + (dir ? 8191 - s_ : s_); }              \
  }
#define SC_LOAD(c, R)                                                            \
  {                                                                              \
    int row; SC_ROW((c) * SC_TOK + tl, row);                                     \
    const bf16_t* zr = ZR + (size_t)row * 1536 + h * 64 + cg4;                   \
    R.gr = *(const u32x2*)zr; R.gk = *(const u32x2*)(zr + 512);                  \
    if (cg4 < 16) R.gv = *(const u32x2*)(ZR + (size_t)row * 1536 + 1024 + h * 64 + rg * 16 + cg4); \
    R.gew = *(const f16x4*)(EW + (size_t)row * 512 + h * 64 + cg4);              \
    R.ga = *(const f16x4*)(AA + (size_t)row * 512 + h * 64 + cg4);               \
    R.gkn = KN[row * 8 + h];                                                     \
  }
#define SC_STAGE(buf, R)                                                         \
  {                                                                              \
    float* dst = IN + ((buf) * SC_TOK + tl) * SC_STRIDE + cg4;                   \
    const float kf[4] = {bflo(R.gk[0]), bfhi(R.gk[0]), bflo(R.gk[1]), bfhi(R.gk[1])}; \
    f32x4 w4, kk4, b4, km4, r4;                                                  \
    r4[0] = bflo(R.gr[0]); r4[1] = bfhi(R.gr[0]); r4[2] = bflo(R.gr[1]); r4[3] = bfhi(R.gr[1]); \
    _Pragma("unroll") for (int j = 0; j < 4; ++j) {                              \
      const float a = (float)R.ga[j];                                            \
      w4[j] = __builtin_amdgcn_exp2f((float)R.gew[j]);     \
      kk4[j] = kf[j] * kkc[j] * R.gkn;                                           \
      b4[j] = -kk4[j] * a;                                                       \
      km4[j] = kf[j] * (1.0f + (a - 1.0f) * kac[j]);                             \
    }                                                                            \
    *(f32x4*)(dst) = w4; *(f32x4*)(dst + 64) = kk4; *(f32x4*)(dst + 128) = b4;   \
    *(f32x4*)(dst + 192) = km4; *(f32x4*)(dst + 256) = r4;                       \
    if (cg4 < 16) {                                                              \
      f32x4 v4; v4[0] = bflo(R.gv[0]); v4[1] = bfhi(R.gv[0]); v4[2] = bflo(R.gv[1]); v4[3] = bfhi(R.gv[1]); \
      *(f32x4*)(IN + ((buf) * SC_TOK + tl) * SC_STRIDE + 320 + cg4) = v4;        \
    }                                                                            \
  }
#define SC_STEP(J)                                                                                            \
    {                                                                                                         \
      if ((J) + 2 < SC_TOK) sc_ld(ops[((J) + 2) % 3], in + ((J) + 2) * SC_STRIDE + kl * 4, in + ((J) + 2) * SC_STRIDE + vidx); \
      const ScOp& o = ops[(J) % 3];                                                                           \
      f32x2 pa = S01 * o.kk.xy;                                                                               \
      pa = S23 * o.kk.zw + pa;                                                                                \
      float sa = pa.x + pa.y;                                                                                 \
      const f32x2 vv = {o.v, o.v};                                                                            \
      f32x2 t01 = vv * o.km.xy, t23 = vv * o.km.zw;                                                           \
      t01 = S01 * o.w.xy + t01;                                                                               \
      t23 = S23 * o.w.zw + t23;                                                                               \
      sa = allreduce16(sa);                                                                                   \
      const f32x2 sv = {sa, sa};                                                                              \
      S01 = sv * o.nb.xy + t01;                                                                               \
      S23 = sv * o.nb.zw + t23;                                                                               \
      f32x2 py = S01 * o.r.xy;                                                                                \
      py = S23 * o.r.zw + py;                                                                                 \
      yp[J] = py.x + py.y;     \
    }
#define SC_CHUNK(BUF)                                                                                         \
    {                                                                                                         \
      const float* in = IN + (BUF) * SC_TOK * SC_STRIDE;                                                      \
      ScOp ops[3];                                                                                            \
      sc_ld(ops[0], in + kl * 4, in + vidx);                                                                  \
      sc_ld(ops[1], in + SC_STRIDE + kl * 4, in + SC_STRIDE + vidx);                                          \
      float yp[16];                                                                                           \
      SC_STEP(0) SC_STEP(1) SC_STEP(2) SC_STEP(3) SC_STEP(4) SC_STEP(5) SC_STEP(6) SC_STEP(7)                 \
      SC_STEP(8) SC_STEP(9) SC_STEP(10) SC_STEP(11) SC_STEP(12) SC_STEP(13) SC_STEP(14) SC_STEP(15)           \
        \
      float ya[8], yb4[4], yc[2];                                                                             \
      _Pragma("unroll") for (int i = 0; i < 8; ++i) {                                                         \
        const float keep = bit3 ? yp[i + 8] : yp[i], send = bit3 ? yp[i] : yp[i + 8];                         \
        ya[i] = keep + dpp_get<0x128>(send);                                         \
      }                                                                                                       \
      _Pragma("unroll") for (int i = 0; i < 4; ++i) {                                                         \
        const float keep = bit2 ? ya[i + 4] : ya[i], send = bit2 ? ya[i] : ya[i + 4];                         \
        yb4[i] = keep + dpp_get<0x141>(send);                                  \
      }                                                                                                       \
      _Pragma("unroll") for (int i = 0; i < 2; ++i) {                                                         \
        const float keep = bit1 ? yb4[i + 2] : yb4[i], send = bit1 ? yb4[i] : yb4[i + 2];                     \
        yc[i] = keep + dpp_get<0x4E>(send);                                \
      }                                                                                                       \
      const float ykeep = bit0 ? yc[1] : yc[0], ysend = bit0 ? yc[0] : yc[1];                                 \
      const float ysel = ykeep + dpp_get<0xB1>(ysend);                     \
      YB[(BUF) * 256 + kl * 16 + wave * 4 + rl] = ysel;                                                       \
    }
#define SC_YOUT(c, BUF)                                                                                       \
    {                                                                                                         \
      int row; SC_ROW((c) * SC_TOK + (tid >> 4), row);                                                        \
      Y[(size_t)row * 512 + h * 64 + rg * 16 + (tid & 15)] = (f16_t)(YB[(BUF) * 256 + tid] * 0.0625f);       \
    }
  constexpr int NCH = NKEY / SC_TOK;
  SC_LOAD(0, RA);
  SC_LOAD(1, RB);
  SC_STAGE(0, RA);
  __syncthreads();
  f32x2 S01 = {0.f, 0.f}, S23 = {0.f, 0.f};
  const int vidx = 320 + wave * 4 + rl;
  const bool bit3 = (kl & 8) != 0, bit2 = (kl & 4) != 0, bit1 = (kl & 2) != 0, bit0 = (kl & 1) != 0;
  __builtin_amdgcn_s_setprio(3);
  for (int c = 0; c < NCH; c += 2) {
    const bool more = (c + 2 < NCH);
    if (more) SC_LOAD(c + 2, RA);
    SC_CHUNK(0);
    SC_STAGE(1, RB);
    __syncthreads();
    SC_YOUT(c, 0);
    if (more) SC_LOAD(c + 3, RB);
    SC_CHUNK(1);
    if (more) SC_STAGE(0, RA);
    __syncthreads();
    SC_YOUT(c + 1, 1);
  }
  __builtin_amdgcn_s_setprio(0);
  __syncthreads();
#undef SC_ROW
#undef SC_LOAD
#undef SC_STAGE
#undef SC_STEP
#undef SC_CHUNK
#undef SC_YOUT
}

constexpr int AT_KB = 8192, AT_VB = 64 * 136;
template <bool SHIFT> DEVI void attn_body(const Params& p, int l, int idx, unsigned char* smem, float lam, float lam_init) {
  const int tid = get_tid(), lane = tid & 63, wave = tid >> 6, r32 = lane & 31, hh = lane >> 5;
  int b, h, qrow0, kt0, kt1;
  if (idx < 2048) { const int bh = idx >> 6, qb = idx & 63; b = bh >> 3; h = bh & 7; qrow0 = b * 8192 + qb * 128; kt0 = 0; kt1 = 132; }
  else { const int j = idx - 2048, bh = j >> 1, qb = j & 1; b = bh >> 3; h = bh & 7; qrow0 = TL + b * 256 + qb * 128; kt0 = 128; kt1 = 132; }
  const bf16_t* QK = (const bf16_t*)(p.ws + OFF_QK);
  const bf16_t* VT = (const bf16_t*)(p.ws + OFF_VT) + (size_t)(b * 8 + h) * 64 * NKEY;
  unsigned char* KB = smem;
  unsigned char* VB = smem + 2 * AT_KB;
  bf16x8 qf[2][2];
  {
    const bf16_t* qp = QK + (size_t)(qrow0 + wave * 32 + r32) * 1024 + h * 64 + hh * 8;
#pragma unroll
    for (int s = 0; s < 2; ++s)
#pragma unroll
      for (int ks = 0; ks < 2; ++ks) qf[s][ks] = *(const bf16x8*)(qp + s * 32 + ks * 16);
  }
  const int lkey = tid >> 2, lc0 = (tid & 3) * 2;
  u32x4 rk0, rk1, rv0, rv1;
#define AT_LOAD(kt)                                                                           \
  {                                                                                           \
    const int kx = (kt) * 64 + lkey;                                                          \
    const int krow = kx < 8192 ? b * 8192 + kx : TL + b * 256 + (kx - 8192);                  \
    const bf16_t* kp = QK + (size_t)krow * 1024 + 512 + h * 64 + lc0 * 8;                     \
    rk0 = *(const u32x4*)kp; rk1 = *(const u32x4*)(kp + 8);                                   \
    const bf16_t* vp = VT + (size_t)lkey * NKEY + (kt) * 64 + lc0 * 8;                        \
    rv0 = *(const u32x4*)vp; rv1 = *(const u32x4*)(vp + 8);                                   \
  }
#define AT_STORE(buf)                                                                         \
  {                                                                                           \
    unsigned char* kb = KB + (buf) * AT_KB + lkey * 128;                                      \
    const int sw = (lkey >> 1) & 7;                                                           \
    *(u32x4*)(kb + ((lc0 ^ sw) << 4)) = rk0;                                                  \
    *(u32x4*)(kb + (((lc0 + 1) ^ sw) << 4)) = rk1;                                            \
    unsigned char* vb = VB + (buf) * AT_VB + lkey * 136 + lc0 * 16;                           \
    u32x2 t;                                                                                  \
    t[0] = rv0[0]; t[1] = rv0[1]; *(u32x2*)(vb) = t;                                          \
    t[0] = rv0[2]; t[1] = rv0[3]; *(u32x2*)(vb + 8) = t;                                      \
    t[0] = rv1[0]; t[1] = rv1[1]; *(u32x2*)(vb + 16) = t;                                     \
    t[0] = rv1[2]; t[1] = rv1[3]; *(u32x2*)(vb + 24) = t;                                     \
  }
  f32x16 O[2][2];
#pragma unroll
  for (int s = 0; s < 2; ++s)
#pragma unroll
    for (int d = 0; d < 2; ++d)
#pragma unroll
      for (int e = 0; e < 16; ++e) O[s][d][e] = 0.f;
  float mref[2];
  f32x2 lacc[2];
  int need = 0;
  {
    const float* KM = (const float*)(p.ws + OFF_KM);
#pragma unroll
    for (int s = 0; s < 2; ++s) {
      float ss = 0.f;
#pragma unroll
      for (int ks = 0; ks < 2; ++ks)
#pragma unroll
        for (int j = 0; j < 8; ++j) { const float v = __uint_as_float(((unsigned)(unsigned short)qf[s][ks][j]) << 16); ss += v * v; }
      ss += shfl_xor_(ss, 32);
      mref[s] = sqrtf(ss * KM[(b * 8 + h) * 2 + s]);
      need |= (mref[s] > 96.0f) ? 1 : 0;
      lacc[s] = (f32x2){0.f, 0.f};
    }
  }
  (void)need;
  const f32x16 zero16 = {0.f, 0.f, 0.f, 0.f, 0.f, 0.f, 0.f, 0.f, 0.f, 0.f, 0.f, 0.f, 0.f, 0.f, 0.f, 0.f};
  AT_LOAD(kt0);
  AT_STORE(0);
  __syncthreads();
  for (int kt = kt0; kt < kt1; ++kt) {
    const int buf = (kt - kt0) & 1;
    const bool more = (kt + 1 < kt1);
    if (more) AT_LOAD(kt + 1);
    const unsigned char* kb = KB + buf * AT_KB;
    const unsigned char* vb = VB + buf * AT_VB;
#define AT_QK(S_, KB_, SC)                                                                                      \
    {                                                                                                           \
      const int key = (KB_) * 32 + r32;                                                                         \
      const bf16x8 kf0 = *(const bf16x8*)(kb + key * 128 + ((((S_) * 4 + hh) ^ ((key >> 1) & 7)) << 4));         \
      const bf16x8 kf1 = *(const bf16x8*)(kb + key * 128 + ((((S_) * 4 + 2 + hh) ^ ((key >> 1) & 7)) << 4));     \
      SC = __builtin_amdgcn_mfma_f32_32x32x16_bf16(kf0, qf[S_][0], zero16, 0, 0, 0);                            \
      SC = __builtin_amdgcn_mfma_f32_32x32x16_bf16(kf1, qf[S_][1], SC, 0, 0, 0);                                \
    }
#define AT_SPV(S_, KB_, SC)                                                                                     \
    {                                                                                                           \
      if (SHIFT) { _Pragma("unroll") for (int e = 0; e < 16; ++e) SC[e] -= mref[S_]; }                          \
      _Pragma("unroll") for (int e = 0; e < 16; ++e) SC[e] = __builtin_amdgcn_exp2f(SC[e]);                     \
      _Pragma("unroll") for (int e = 0; e < 8; ++e) lacc[S_] += (f32x2){SC[2 * e], SC[2 * e + 1]};              \
      _Pragma("unroll") for (int s2 = 0; s2 < 2; ++s2) {                                                        \
        u32x4 w;                                                                                                \
        w[0] = pk_bf16(SC[8 * s2 + 0], SC[8 * s2 + 1]); w[1] = pk_bf16(SC[8 * s2 + 2], SC[8 * s2 + 3]);         \
        w[2] = pk_bf16(SC[8 * s2 + 4], SC[8 * s2 + 5]); w[3] = pk_bf16(SC[8 * s2 + 6], SC[8 * s2 + 7]);         \
        const bf16x8 pf = __builtin_bit_cast(bf16x8, w);                                                        \
        _Pragma("unroll") for (int d = 0; d < 2; ++d) {                                                         \
          const unsigned char* vp = vb + (d * 32 + r32) * 136 + ((KB_) * 32 + 16 * s2 + 4 * hh) * 2;            \
          const u32x2 v0 = *(const u32x2*)vp, v1 = *(const u32x2*)(vp + 16);                                    \
          u32x4 vv; vv[0] = v0[0]; vv[1] = v0[1]; vv[2] = v1[0]; vv[3] = v1[1];                                 \
          const bf16x8 vf = __builtin_bit_cast(bf16x8, vv);                                                     \
          O[S_][d] = __builtin_amdgcn_mfma_f32_32x32x16_bf16(vf, pf, O[S_][d], 0, 0, 0);                        \
        }                                                                                                       \
      }                                                                                                         \
    }
    {
      f32x16 scA, scB;
      AT_QK(0, 0, scA);
      AT_QK(0, 1, scB);
      AT_SPV(0, 0, scA);
      AT_QK(1, 0, scA);
      AT_SPV(0, 1, scB);
      AT_QK(1, 1, scB);
      AT_SPV(1, 0, scA);
      AT_SPV(1, 1, scB);
    }
#undef AT_QK
#undef AT_SPV
    if (more) AT_STORE(buf ^ 1);
    __syncthreads();
  }
  float l1 = lacc[0].x + lacc[0].y, l2 = lacc[1].x + lacc[1].y;
  l1 += shfl_xor_(l1, 32); l2 += shfl_xor_(l2, 32);
  const float i1 = 1.0f / l1, i2 = lam / l2;
  float ss = 0.f;
#pragma unroll
  for (int d = 0; d < 2; ++d)
#pragma unroll
    for (int e = 0; e < 16; ++e) { const float o = O[0][d][e] * i1 - O[1][d][e] * i2; O[0][d][e] = o; ss += o * o; }
  ss += shfl_xor_(ss, 32);
  const float rstd = rsqrtf(ss * (1.0f / 64.0f) + 1e-5f) * (1.0f - lam_init);
  bf16_t* Oo = (bf16_t*)(p.ws + OFF_H) + (size_t)(qrow0 + wave * 32 + r32) * 1024 + 512 + h * 64;
  const float* sg = p.subln_g + l * 64;
#pragma unroll
  for (int d = 0; d < 2; ++d)
#pragma unroll
    for (int jq = 0; jq < 4; ++jq) {
      const int dv = d * 32 + 8 * jq + 4 * hh;
      const f32x4 g4 = *(const f32x4*)(sg + dv);
      u32x2 w;
      w[0] = pk_bf16(O[0][d][4 * jq + 0] * rstd * g4[0], O[0][d][4 * jq + 1] * rstd * g4[1]);
      w[1] = pk_bf16(O[0][d][4 * jq + 2] * rstd * g4[2], O[0][d][4 * jq + 3] * rstd * g4[3]);
      *(u32x2*)(Oo + dv) = w;
    }
#undef AT_LOAD
#undef AT_STORE
}

DEVI void attn_item(const Params& p, int l, int idx, unsigned char* smem, float lam, float lam_init) {
  const int tid = get_tid(), lane = tid & 63, wave = tid >> 6, r32 = lane & 31, hh = lane >> 5;
  int b, h, qrow0;
  if (idx < 2048) { const int bh = idx >> 6, qb = idx & 63; b = bh >> 3; h = bh & 7; qrow0 = b * 8192 + qb * 128; }
  else { const int j = idx - 2048, bh = j >> 1, qb = j & 1; b = bh >> 3; h = bh & 7; qrow0 = TL + b * 256 + qb * 128; }
  const bf16_t* qp = (const bf16_t*)(p.ws + OFF_QK) + (size_t)(qrow0 + wave * 32 + r32) * 1024 + h * 64 + hh * 8;
  const float* KM = (const float*)(p.ws + OFF_KM);
  int need = 0;
#pragma unroll
  for (int s = 0; s < 2; ++s) {
    float ss = 0.f;
#pragma unroll
    for (int ks = 0; ks < 2; ++ks) {
      const u32x4 v = *(const u32x4*)(qp + s * 32 + ks * 16);
#pragma unroll
      for (int j = 0; j < 4; ++j) { const float a = bflo(v[j]), c = bfhi(v[j]); ss += a * a + c * c; }
    }
    ss += shfl_xor_(ss, 32);
    need |= (sqrtf(ss * KM[(b * 8 + h) * 2 + s]) > 96.0f) ? 1 : 0;
  }
  need = __syncthreads_or(need);
  if (need) attn_body<true>(p, l, idx, smem, lam, lam_init);
  else attn_body<false>(p, l, idx, smem, lam, lam_init);
}

DEVI void kmax_job(const Params& p, unsigned char* smem) {
  const int tid = get_tid();
  const bf16_t* QK = (const bf16_t*)(p.ws + OFF_QK);
  float* red = (float*)smem;
  for (int item = blockIdx.x; item < NB * 16 * 8; item += gridDim.x) {
    const int bhs = item >> 3, chunk = item & 7, b = bhs >> 4, hs = bhs & 15;
    float mx = 0.f;
    for (int kx = chunk * 1056 + tid; kx < (chunk + 1) * 1056; kx += 256) {
      const int row = kx < 8192 ? b * 8192 + kx : TL + b * 256 + (kx - 8192);
      const bf16_t* kp = QK + (size_t)row * 1024 + 512 + hs * 32;
      float ss = 0.f;
#pragma unroll
      for (int c = 0; c < 4; ++c) {
        const u32x4 v = *(const u32x4*)(kp + c * 8);
#pragma unroll
        for (int j = 0; j < 4; ++j) { const float a = bflo(v[j]), bb = bfhi(v[j]); ss += a * a + bb * bb; }
      }
      mx = fmaxf(mx, ss);
    }
#pragma unroll
    for (int o = 32; o >= 1; o >>= 1) mx = fmaxf(mx, shfl_xor_(mx, o));
    if ((tid & 63) == 0) red[tid >> 6] = mx;
    __syncthreads();
    if (tid == 0) atomicMax((int*)(p.ws + OFF_KM) + bhs, __float_as_int(fmaxf(fmaxf(red[0], red[1]), fmaxf(red[2], red[3]))));
    __syncthreads();
  }
}

DEVI void phase_mixers(const Params& p, int l, unsigned char* smem, const Place& pl) {
  int* ctr = (int*)(p.ws + OFF_CTR) + l;
  int* s_item = (int*)(smem + 65536 - 16);
  const float lam_init = 0.8f - 0.6f * __expf(-0.3f * (float)l);
  float d1 = 0.f, d2 = 0.f;
  for (int i = 0; i < 32; ++i) { d1 += p.lam_q1[l * 32 + i] * p.lam_k1[l * 32 + i]; d2 += p.lam_q2[l * 32 + i] * p.lam_k2[l * 32 + i]; }
  const float lam = __expf(d1) - __expf(d2) + lam_init;
  const int nattn = 2048 + (l < DEPTH - 1 ? 64 : 0);
  int* ctr_s = ctr;
  int* ctr_a = ctr + 16;
  int mode = pl.scanpref ? 0 : 1;
  while (true) {
    if (get_tid() == 0) {
      int it = -1;
      if (mode == 0) { const int i = atomicAdd(ctr_s, 1); if (i < 256) it = i; else mode = 1; }
      if (it < 0 && mode == 1) { const int j = atomicAdd(ctr_a, 1); if (j < nattn) it = 256 + j; else mode = 2; }
      if (it < 0 && mode == 2) { const int i = atomicAdd(ctr_s, 1); if (i < 256) it = i; }
      s_item[0] = it; s_item[1] = mode;
    }
    __syncthreads();
    const int item = s_item[0];
    mode = s_item[1];
    __syncthreads();
    if (item < 0) break;
    if (item < 256) scan_item(p, l, item, smem);
    else attn_item(p, l, item - 256, smem, lam, lam_init);
  }
}

DEVI void finish(const Params& p, int l) {
  const int nrows = (l == DEPTH - 1) ? TL : NT;
  const f16_t* Y0 = (const f16_t*)(p.ws + OFF_Y);
  const f16_t* Y1 = Y0 + (size_t)NT * 512;
  const bf16_t* ZR = (const bf16_t*)(p.ws + OFF_ZR);
  const f16_t* GATE = (const f16_t*)(p.ws + OFF_GATE);
  bf16_t* Oo = (bf16_t*)(p.ws + OFF_H);
  const int total = nrows * 64;
  for (int idx = blockIdx.x * 256 + get_tid(); idx < total; idx += gridDim.x * 256) {
    const int row = idx >> 6, col = (idx & 63) * 8;
    const f16x8 y0 = __builtin_nontemporal_load((const f16x8*)(Y0 + (size_t)row * 512 + col)), y1 = __builtin_nontemporal_load((const f16x8*)(Y1 + (size_t)row * 512 + col));
    float y[8], s = 0.f;
#pragma unroll
    for (int j = 0; j < 8; ++j) { y[j] = ((float)y0[j] + (float)y1[j]) * 16.0f; s += y[j]; }
    s += shfl_xor_(s, 1); s += shfl_xor_(s, 2); s += shfl_xor_(s, 4);
    const float mu = s * (1.0f / 64.0f);
    float q = 0.f;
#pragma unroll
    for (int j = 0; j < 8; ++j) { y[j] -= mu; q += y[j] * y[j]; }
    q += shfl_xor_(q, 1); q += shfl_xor_(q, 2); q += shfl_xor_(q, 4);
    const float rstd = rsqrtf(q * (1.0f / 64.0f) + 64e-5f);
    const bf16_t* zr = ZR + (size_t)row * 1536 + col;
    const u32x4 ru = __builtin_nontemporal_load((const u32x4*)zr), ku = __builtin_nontemporal_load((const u32x4*)(zr + 512)), vu = __builtin_nontemporal_load((const u32x4*)(zr + 1024));
    float rf[8], kf[8], vf[8];
#pragma unroll
    for (int j = 0; j < 4; ++j) {
      rf[2 * j] = bflo(ru[j]); rf[2 * j + 1] = bfhi(ru[j]);
      kf[2 * j] = bflo(ku[j]); kf[2 * j + 1] = bfhi(ku[j]);
      vf[2 * j] = bflo(vu[j]); vf[2 * j + 1] = bfhi(vu[j]);
    }
    const float* rkp = p.r_k + l * 512 + col;
    const f32x4 rk0 = *(const f32x4*)rkp, rk1 = *(const f32x4*)(rkp + 4);
    float rk = 0.f;
#pragma unroll
    for (int j = 0; j < 4; ++j) rk += rf[j] * kf[j] * rk0[j] + rf[4 + j] * kf[4 + j] * rk1[j];
    rk += shfl_xor_(rk, 1); rk += shfl_xor_(rk, 2); rk += shfl_xor_(rk, 4);
    const f16x8 gt = __builtin_nontemporal_load((const f16x8*)(GATE + (size_t)row * 512 + col));
    const float* lg = p.lnx_g + l * 512 + col;
    const float* lb = p.lnx_b + l * 512 + col;
    const f32x4 g0 = *(const f32x4*)lg, g1 = *(const f32x4*)(lg + 4), b0 = *(const f32x4*)lb, b1 = *(const f32x4*)(lb + 4);
    float o[8];
#pragma unroll
    for (int j = 0; j < 8; ++j) {
      const float gg = j < 4 ? g0[j & 3] : g1[j & 3], bb = j < 4 ? b0[j & 3] : b1[j & 3];
      o[j] = ((y[j] * rstd * gg + bb) + rk * vf[j]) * (float)gt[j];
    }
    u32x4 w;
#pragma unroll
    for (int j = 0; j < 4; ++j) w[j] = pk_bf16(o[2 * j], o[2 * j + 1]);
    *(u32x4*)(Oo + (size_t)row * 1024 + col) = w;
  }
}

DEVI void run_phase(const Params& p, int ph, unsigned char* smem, const Place& pl) {
  if (ph == 0) { phase_setup(p, smem); return; }
  if (ph == 1) { rowpass(p, 0, 0); return; }
  const int l = (ph - 2) / 10, s = (ph - 2) % 10;
  const int nrows = (l == DEPTH - 1) ? TL : NT;
  bf16_t* W = (bf16_t*)(p.ws + OFF_W);
  GemmJob g;
  switch (s) {
    case 0:
      g.A = (const bf16_t*)(p.ws + OFF_H); g.lda = 1024; g.Bt = W; g.K = 1024; g.M = NT; g.N = INC; g.epi = EPI_G1;
      g.out = nullptr; g.ldc = 0; g.bias = nullptr;
      gemm_run<EPI_G1>(p, g, smem, pl);
      break;
    case 1:
      if (blockIdx.x == 0) { const int t_ = get_tid(); if (t_ < 64) ((int*)(p.ws + OFF_KM))[t_] = 0; }
      p1_shift(p, l);
      p1_rope(p);
      break;
    case 2: {
      const bf16_t* LW = (const bf16_t*)(p.ws + OFF_LW) + (size_t)l * 196608;
      const bf16_t* LA = (const bf16_t*)(p.ws + OFF_LA);
      kmax_job(p, smem);
      g.lda = 256; g.M = NT; g.N = 512; g.ldc = 512;
      for (int j = 0; j < 2; ++j) {
        g.A = LA; g.Bt = LW + j * 32768; g.K = 64; g.epi = EPI_EW; g.out = p.ws + OFF_EW + (size_t)j * SZ_T512x2; g.bias = p.w0 + (l * 2 + j) * 512;
        gemm_run<EPI_EW>(p, g, smem, pl);
      }
      for (int j = 0; j < 2; ++j) {
        g.A = LA + 64; g.Bt = LW + 65536 + j * 32768; g.K = 64; g.epi = EPI_SIG; g.out = p.ws + OFF_AA + (size_t)j * SZ_T512x2; g.bias = p.a0 + (l * 2 + j) * 512;
        gemm_run<EPI_SIG>(p, g, smem, pl);
      }
      g.A = LA + 128; g.Bt = LW + 131072; g.K = 128; g.epi = EPI_F16; g.out = p.ws + OFF_GATE; g.bias = nullptr;
      gemm_run<EPI_F16>(p, g, smem, pl);
      break;
    }
    case 3:
      phase_mixers(p, l, smem, pl);
      break;
    case 4:
      finish(p, l);
      convert_matrix(p.w_out + (size_t)l * 1024 * 1024, 1024, 1024, W, smem);
      convert_matrix(p.w_ff1 + (size_t)l * 1024 * 4096, 1024, 4096, W + 1024 * 1024, smem);
      convert_matrix(p.w_ff2 + (size_t)l * 4096 * 1024, 4096, 1024, W + 1024 * 1024 + 4096 * 1024, smem);
      break;
    case 5:
      g.A = (const bf16_t*)(p.ws + OFF_H); g.lda = 1024; g.Bt = W; g.K = 1024; g.M = nrows; g.N = 1024; g.epi = EPI_BF16;
      g.out = p.ws + OFF_F; g.ldc = 1024; g.bias = nullptr;
      gemm_run<EPI_BF16>(p, g, smem, pl);
      break;
    case 6:
      rowpass(p, 1, l);
      break;
    case 7:
      g.A = (const bf16_t*)(p.ws + OFF_H); g.lda = 1024; g.Bt = W + 1024 * 1024; g.K = 1024; g.M = nrows; g.N = 4096; g.epi = EPI_RELU2;
      g.out = p.ws + OFF_HID; g.ldc = 4096; g.bias = nullptr;
      gemm_run<EPI_RELU2>(p, g, smem, pl);
      break;
    case 8:
      g.A = (const bf16_t*)(p.ws + OFF_HID); g.lda = 4096; g.Bt = W + 1024 * 1024 + 4096 * 1024; g.K = 4096; g.M = nrows; g.N = 1024; g.epi = EPI_BF16;
      g.out = p.ws + OFF_F; g.ldc = 1024; g.bias = nullptr;
      gemm_run<EPI_BF16>(p, g, smem, pl);
      break;
    case 9:
      rowpass(p, 2, l);
      if (l + 1 < DEPTH) convert_matrix(p.w_in + (size_t)(l + 1) * 1024 * INC, 1024, INC, W, smem);
      break;
  }
}


#define XB_TMO      128
#define XB_XCNT(j)  (256  + 64 * (j))
#define XB_XSUB(j)  (1280 + 64 * (j))
#define XB_XGEN(j)  (2304 + 64 * (j))
#define XB_TOP      3328
#define XB_TOPGEN   3392
#define XB_PAR      192
#define XCD_BAR_WORDS 3456
#define XB_SPIN_CAP (1u << 22)
DEVI unsigned xb_ld(unsigned* p) { return __hip_atomic_load(p, __ATOMIC_RELAXED, __HIP_MEMORY_SCOPE_AGENT); }
DEVI unsigned xb_add(unsigned* p, unsigned v) { return __hip_atomic_fetch_add(p, v, __ATOMIC_RELAXED, __HIP_MEMORY_SCOPE_AGENT); }
DEVI unsigned xb_xcc_id() { return (unsigned)__builtin_amdgcn_s_getreg((3 << 11) | 20) & 0xFu; }
#define XB_SPIN(cond, bar) do { unsigned _sp = 0; while (cond) { __builtin_amdgcn_s_sleep(1); \
    if ((++_sp & 255u) == 0u) { if (xb_ld(&(bar)[XB_TMO])) break; if (_sp > XB_SPIN_CAP) { atomicAdd(&(bar)[XB_TMO], 1u); break; } } } } while (0)
DEVI void xcd_barrier(unsigned* bar, unsigned x, unsigned nloc, unsigned nx) {
  asm volatile("s_waitcnt vmcnt(0)" ::: "memory");
  __syncthreads();
  if (threadIdx.x == 0) {
    __builtin_amdgcn_s_waitcnt(0);
    const unsigned old = xb_add(&bar[XB_XSUB(x)], 1u);
    const unsigned gen = old / nloc;
    if (old + 1u == (gen + 1u) * nloc) {
      __builtin_amdgcn_fence(__ATOMIC_RELEASE, "agent");
      asm volatile("s_waitcnt vmcnt(0)" ::: "memory");
      const unsigned og = xb_add(&bar[XB_TOP], 1u);
      const unsigned tg = og / nx;
      if (og + 1u == (tg + 1u) * nx) xb_add(&bar[XB_TOPGEN], 1u);
      else XB_SPIN(xb_ld(&bar[XB_TOPGEN]) == tg, bar);
      __builtin_amdgcn_fence(__ATOMIC_ACQUIRE, "agent");
      xb_add(&bar[XB_XGEN(x)], 1u);
      asm volatile("s_waitcnt vmcnt(0)" ::: "memory");
    } else {
      XB_SPIN(xb_ld(&bar[XB_XGEN(x)]) == gen, bar);
      __builtin_amdgcn_fence(__ATOMIC_ACQUIRE, "agent");
      asm volatile("s_waitcnt vmcnt(0)" ::: "memory");
    }
  }
  __syncthreads();
}

__global__ void __launch_bounds__(256, 2) fwd_megakernel(Params p, int ph0, int ph1) {
  __shared__ __attribute__((aligned(16))) unsigned char smem[65536];
  cg::grid_group grid = cg::this_grid();
  unsigned* bar = (unsigned*)(p.ws + OFF_BAR);
  const unsigned xcc = xb_xcc_id();
  unsigned nloc = 1u, nx = 1u;
  const bool coop = (ph1 - ph0 > 1);
  Place pl; pl.xcc = (int)xcc; pl.rank = 0; pl.swz = 0; pl.scanpref = 1;
  const unsigned cu_par = ((unsigned)__builtin_amdgcn_s_getreg((15 << 11) | 4) >> 8) & 1u;
  if (coop) {
    if (threadIdx.x == 0 && cu_par) (void)xb_add(&bar[XB_PAR], 1u);
    if (threadIdx.x == 0) *(volatile unsigned*)smem = xb_add(&bar[XB_XCNT(xcc)], 1u);
    __syncthreads();
    pl.rank = __builtin_amdgcn_readfirstlane((int)*(volatile unsigned*)smem);
    __syncthreads();
  }
  for (int ph = ph0; ph < ph1; ++ph) {
    run_phase(p, ph, smem, pl);
    if (ph + 1 < ph1) {
      if (ph == ph0) {
        grid.sync();
        if (threadIdx.x == 0) {
          unsigned cnt = 0u, mine = 0u, ok = (gridDim.x == 512u) ? 1u : 0u;
#pragma unroll
          for (unsigned j = 0; j < 16; ++j) {
            const unsigned c = xb_ld(&bar[XB_XCNT(j)]);
            cnt += (c > 0u) ? 1u : 0u; mine = (j == xcc) ? c : mine;
            if (j < 8 ? (c != 64u) : (c != 0u)) ok = 0u;
          }
          nloc = mine > 0u ? mine : 1u; nx = cnt > 0u ? cnt : 1u;
          const unsigned n_odd = xb_ld(&bar[XB_PAR]), n_even = gridDim.x - n_odd;
          const unsigned scan_class = (n_even >= 256u) ? 0u : 1u;
          ((volatile unsigned*)smem)[0] = ok;
          ((volatile unsigned*)smem)[1] = (cu_par == scan_class) ? 1u : 0u;
        }
        __syncthreads();
        pl.swz = __builtin_amdgcn_readfirstlane((int)((volatile unsigned*)smem)[0]);
        pl.scanpref = __builtin_amdgcn_readfirstlane((int)((volatile unsigned*)smem)[1]);
        __syncthreads();
      } else {
        xcd_barrier(bar, xcc, nloc, nx);
      }
    }
  }
}

extern "C" void kernel_launch(void* const* d_in, const int* in_sizes, int n_in, void* d_out, int out_size,
                              void* d_ws, size_t ws_size, hipStream_t stream) {
  static int grid_blocks = 0;
  if (!grid_blocks) {
    int dev = 0, cus = 0, per_cu = 0;
    hipGetDevice(&dev);
    hipDeviceGetAttribute(&cus, hipDeviceAttributeMultiprocessorCount, dev);
    hipOccupancyMaxActiveBlocksPerMultiprocessor(&per_cu, fwd_megakernel, 256, 0);
    if (per_cu < 1) per_cu = 1;
    if (per_cu > 2) per_cu = 2;
    grid_blocks = cus * per_cu;
  }
  Params p{};
  const float** pp = (const float**)&p;
  for (int i = 0; i < 30; ++i) pp[i] = (const float*)d_in[i];
  p.out = (float*)d_out;
  p.ws = (unsigned char*)d_ws;
  if (ws_size < WS_END) { fprintf(stderr, "workspace too small: %zu < %zu\n", ws_size, (size_t)WS_END); return; }
  hipMemsetAsync(p.ws + OFF_BAR, 0, XCD_BAR_WORDS * 4, stream);
#if MULTI_LAUNCH
  for (int ph = 0; ph < NPH; ++ph) {
    hipLaunchKernelGGL(fwd_megakernel, dim3(grid_blocks), dim3(256), 0, stream, p, ph, ph + 1);
  }
#else
  int ph0 = 0, ph1 = NPH;
  void* args[] = {&p, &ph0, &ph1};
  hipError_t e = hipLaunchCooperativeKernel((void*)fwd_megakernel, dim3(grid_blocks), dim3(256), args, 0, stream);
  if (e != hipSuccess) fprintf(stderr, "cooperative launch failed: %s (grid %d)\n", hipGetErrorString(e), grid_blocks);
#endif
}
```

```cpp
#include <hip/hip_runtime.h>
#include <hip/hip_cooperative_groups.h>
#include <cstdio>
#include <cstdint>
namespace cg = cooperative_groups;

#ifndef MULTI_LAUNCH
#define MULTI_LAUNCH 0
#endif

#define DEVI __device__ __forceinline__
#define LDS_AS __attribute__((address_space(3)))
typedef unsigned short bf16_t;
typedef _Float16 f16_t;
typedef short bf16x8 __attribute__((ext_vector_type(8)));
typedef float f32x16 __attribute__((ext_vector_type(16)));
typedef float f32x4 __attribute__((ext_vector_type(4)));
typedef unsigned u32x4 __attribute__((ext_vector_type(4)));
typedef unsigned u32x2 __attribute__((ext_vector_type(2)));
typedef _Float16 f16x4 __attribute__((ext_vector_type(4)));
typedef _Float16 f16x8 __attribute__((ext_vector_type(8)));

constexpr int DM = 1024, NB = 4, SEQ = 8192, DEPTH = 4, CTX = 256;
constexpr int TL = NB * SEQ, TC = NB * CTX, NT = TL + TC;
constexpr int RC = 1792, INC = 3328, DFF = 4096, NKEY = SEQ + CTX;
constexpr int NPH = 2 + DEPTH * 10;

constexpr size_t SZ_T512x2 = (size_t)NT * 512 * 2;
constexpr size_t OFF_QK = 0;
constexpr size_t OFF_VT = OFF_QK + 2 * SZ_T512x2;
constexpr size_t OFF_ZR = OFF_VT + SZ_T512x2;
constexpr size_t OFF_Y = OFF_ZR + 3 * SZ_T512x2;
constexpr size_t OFF_LA = OFF_Y;
constexpr size_t OFF_HID = 0;
constexpr size_t OFF_B = 8 * SZ_T512x2;
constexpr size_t OFF_GATE = OFF_B;
constexpr size_t OFF_EW = OFF_B + SZ_T512x2;
constexpr size_t OFF_AA = OFF_B + 3 * SZ_T512x2;
constexpr size_t OFF_F = OFF_B;
constexpr size_t OFF_ZA = OFF_B;
constexpr size_t SZ_W = (size_t)(1024 * 1024 + 2 * 1024 * 4096) * 2;
constexpr size_t OFF_W = OFF_B + 5 * SZ_T512x2 - SZ_W;
constexpr size_t OFF_H = OFF_B + 5 * SZ_T512x2;
constexpr size_t OFF_XC = OFF_H + 2 * SZ_T512x2;
constexpr size_t OFF_KN = OFF_XC + (size_t)TC * 1024 * 4;
constexpr size_t OFF_MOD = OFF_KN + (size_t)NT * 8 * 4;
constexpr size_t OFF_LW = OFF_MOD + (size_t)DEPTH * 5 * 6144 * 4;
constexpr size_t OFF_ROPE = OFF_LW + (size_t)DEPTH * 196608 * 2;
constexpr size_t OFF_CTR = OFF_ROPE + 128 * 8 * 8;
constexpr size_t OFF_KM = OFF_CTR + 256;
constexpr size_t OFF_BAR = OFF_KM + 256;
constexpr size_t WS_END = OFF_BAR + 3456 * 4;
static_assert((size_t)NT * 1024 * 4 <= 5 * SZ_T512x2 - SZ_W, "F overlaps W");
static_assert((size_t)NT * RC * 2 <= 5 * SZ_T512x2 - SZ_W, "ZA overlaps W");
static_assert(WS_END <= (size_t)536870912, "workspace too big");

struct Params {
  const float *x, *c, *ctx, *c_ctx, *ada_w, *ada_b, *g_pre_mix, *g_post_mix, *g_pre_mlp, *g_post_mlp,
      *w_in, *shift_mu, *k_k, *k_a, *w0, *w_b, *a0, *a_b, *g_b, *r_k, *lnx_g, *lnx_b,
      *lam_q1, *lam_k1, *lam_q2, *lam_k2, *subln_g, *w_out, *w_ff1, *w_ff2;
  float* out;
  unsigned char* ws;
};

DEVI unsigned pk_bf16(float lo, float hi) {
  unsigned r;
  asm("v_cvt_pk_bf16_f32 %0, %1, %2" : "=v"(r) : "v"(lo), "v"(hi));
  return r;
}
DEVI bf16_t f2bf(float f) { return (bf16_t)(pk_bf16(f, 0.f) & 0xffffu); }
DEVI float bflo(unsigned u) { return __uint_as_float(u << 16); }
DEVI float bfhi(unsigned u) { return __uint_as_float(u & 0xffff0000u); }
DEVI int get_tid() { int t = threadIdx.x; asm volatile("" : "+v"(t)); return t; }
DEVI float sigmoidf_(float x) { return __builtin_amdgcn_rcpf(1.0f + __expf(-x)); }
DEVI int lane_id_() { int l = (int)__builtin_amdgcn_mbcnt_hi(~0u, __builtin_amdgcn_mbcnt_lo(~0u, 0u)); asm volatile("" : "+v"(l)); return l; }
DEVI float shfl_xor_(float v, int o) { return __int_as_float(__builtin_amdgcn_ds_bpermute((lane_id_() ^ o) << 2, __float_as_int(v))); }
DEVI float wave_sum(float v) {
#pragma unroll
  for (int o = 32; o >= 1; o >>= 1) v += shfl_xor_(v, o);
  return v;
}
template <int CTRL> DEVI float dpp_add(float v) {
  int t = __builtin_amdgcn_update_dpp(0, __float_as_int(v), CTRL, 0xf, 0xf, true);
  return v + __int_as_float(t);
}
template <int CTRL> DEVI float dpp_get(float v) {
  return __int_as_float(__builtin_amdgcn_update_dpp(0, __float_as_int(v), CTRL, 0xf, 0xf, true));
}
DEVI float allreduce16(float v) {
  v = dpp_add<0xB1>(v);
  v = dpp_add<0x4E>(v);
  v = dpp_add<0x141>(v);
  v = dpp_add<0x140>(v);
  return v;
}
DEVI float* xrow(const Params& p, int row) {
  return row < TL ? p.out + (size_t)row * 1024 : (float*)(p.ws + OFF_XC) + (size_t)(row - TL) * 1024;
}
DEVI const float* xin_row(const Params& p, int row) {
  return row < TL ? p.x + (size_t)row * 1024 : p.ctx + (size_t)(row - TL) * 1024;
}
DEVI int mod_idx(int row) { return row < TL ? (row >> 13) : 4; }

DEVI void convert_tile(const float* __restrict__ src, int K, int N, bf16_t* __restrict__ dst, int tk, int tn,
                       unsigned char* smem) {
  float* tile = (float*)smem;
  const int tid = get_tid();
  {
    const int kr = tid >> 4, nc = (tid & 15) * 4;
#pragma unroll
    for (int i = 0; i < 4; ++i) {
      const int k = kr + i * 16;
      const f32x4 v = __builtin_nontemporal_load((const f32x4*)(src + (size_t)(tk * 64 + k) * N + tn * 64 + nc));
      tile[k * 65 + nc + 0] = v[0]; tile[k * 65 + nc + 1] = v[1];
      tile[k * 65 + nc + 2] = v[2]; tile[k * 65 + nc + 3] = v[3];
    }
  }
  __syncthreads();
  {
    const int n = tid >> 2, kc = (tid & 3) * 16;
    u32x4 o0, o1;
    o0[0] = pk_bf16(tile[(kc + 0) * 65 + n], tile[(kc + 1) * 65 + n]);
    o0[1] = pk_bf16(tile[(kc + 2) * 65 + n], tile[(kc + 3) * 65 + n]);
    o0[2] = pk_bf16(tile[(kc + 4) * 65 + n], tile[(kc + 5) * 65 + n]);
    o0[3] = pk_bf16(tile[(kc + 6) * 65 + n], tile[(kc + 7) * 65 + n]);
    o1[0] = pk_bf16(tile[(kc + 8) * 65 + n], tile[(kc + 9) * 65 + n]);
    o1[1] = pk_bf16(tile[(kc + 10) * 65 + n], tile[(kc + 11) * 65 + n]);
    o1[2] = pk_bf16(tile[(kc + 12) * 65 + n], tile[(kc + 13) * 65 + n]);
    o1[3] = pk_bf16(tile[(kc + 14) * 65 + n], tile[(kc + 15) * 65 + n]);
    bf16_t* d = dst + (size_t)(tn * 64 + n) * K + tk * 64 + kc;
    *(u32x4*)d = o0;
    *(u32x4*)(d + 8) = o1;
  }
  __syncthreads();
}
DEVI void convert_matrix(const float* src, int K, int N, bf16_t* dst, unsigned char* smem) {
  const int nk = K / 64, nn = N / 64;
  for (int t = blockIdx.x; t < nk * nn; t += gridDim.x) convert_tile(src, K, N, dst, t / nn, t % nn, smem);
}

enum { EPI_F32 = 0, EPI_BF16 = 1, EPI_RELU2 = 2, EPI_EW = 3, EPI_SIG = 4, EPI_F16 = 5, EPI_G1 = 6 };
struct GemmJob {
  const bf16_t* A; int lda;
  const bf16_t* Bt;
  int K, M, N, epi;
  void* out; int ldc;
  const float* bias;
};

template <int EPI> DEVI void gemm_tile(const Params& p, const GemmJob& g, int tm, int tn, unsigned char* smem) {
  const int tid = get_tid(), lane = tid & 63, wave = tid >> 6;
  const int wm = wave >> 1, wn = wave & 1, r32 = lane & 31, hh = lane >> 5;
  const int lrow = tid >> 3, lch = tid & 7;
  const bf16_t* Ag[4];
  const bf16_t* Bg[4];
#pragma unroll
  for (int i = 0; i < 4; ++i) {
    const int row = lrow + i * 32, c = lch ^ ((row >> 1) & 7);
    Ag[i] = g.A + (size_t)(tm * 128 + row) * g.lda + c * 8;
    Bg[i] = g.Bt + (size_t)(tn * 128 + row) * g.K + c * 8;
  }
  f32x16 acc[2][2];
#pragma unroll
  for (int i = 0; i < 2; ++i)
#pragma unroll
    for (int j = 0; j < 2; ++j)
#pragma unroll
      for (int e = 0; e < 16; ++e) acc[i][j][e] = 0.f;
  const int nk = g.K >> 6;
  unsigned char* lds_t = smem + tid * 16;
#define GEMM_STAGE(kt_, buf_)                                                                                   \
  {                                                                                                             \
    _Pragma("unroll") for (int i = 0; i < 4; ++i) {                                                             \
      __builtin_amdgcn_global_load_lds((const unsigned*)(Ag[i] + (kt_) * 64), (LDS_AS unsigned*)(lds_t + (buf_) * 32768 + i * 4096), 16, 0, 0);          \
      __builtin_amdgcn_global_load_lds((const unsigned*)(Bg[i] + (kt_) * 64), (LDS_AS unsigned*)(lds_t + (buf_) * 32768 + 16384 + i * 4096), 16, 0, 0);  \
    }                                                                                                           \
  }
  GEMM_STAGE(0, 0);
  asm volatile("s_waitcnt vmcnt(0)" ::: "memory");
  __syncthreads();
  int aoff[2], boff[2];
#pragma unroll
  for (int mi = 0; mi < 2; ++mi) { const int row = wm * 64 + mi * 32 + r32; aoff[mi] = row * 128; }
#pragma unroll
  for (int ni = 0; ni < 2; ++ni) { const int row = wn * 64 + ni * 32 + r32; boff[ni] = 16384 + row * 128; }
  const int sw = (r32 >> 1) & 7;
  for (int kt = 0; kt < nk; ++kt) {
    const bool more = (kt + 1 < nk);
    const unsigned char* base = smem + (kt & 1) * 32768;
    bf16x8 a[4][2], b[4][2];
#pragma unroll
    for (int ks = 0; ks < 4; ++ks) {
      const int co = ((ks * 2 + hh) ^ sw) << 4;
#pragma unroll
      for (int mi = 0; mi < 2; ++mi) a[ks][mi] = *(const bf16x8*)(base + aoff[mi] + co);
#pragma unroll
      for (int ni = 0; ni < 2; ++ni) b[ks][ni] = *(const bf16x8*)(base + boff[ni] + co);
    }
    __builtin_amdgcn_sched_barrier(0);
    if (more) GEMM_STAGE(kt + 1, (kt + 1) & 1);
    __builtin_amdgcn_sched_barrier(0);
#pragma unroll
    for (int ks = 0; ks < 4; ++ks)
#pragma unroll
      for (int mi = 0; mi < 2; ++mi)
#pragma unroll
        for (int ni = 0; ni < 2; ++ni)
          acc[mi][ni] = __builtin_amdgcn_mfma_f32_32x32x16_bf16(a[ks][mi], b[ks][ni], acc[mi][ni], 0, 0, 0);
    __builtin_amdgcn_sched_barrier(0);
    asm volatile("s_waitcnt vmcnt(0)" ::: "memory");
    __syncthreads();
  }
#undef GEMM_STAGE
  const int row_b = tm * 128 + wm * 64 + 4 * hh, col_b = tn * 128 + wn * 64 + r32;
  constexpr int epi = EPI;
  if (epi == EPI_G1 && tn >= 22) {
    bf16_t* VT = (bf16_t*)(p.ws + OFF_VT);
#pragma unroll
    for (int mi = 0; mi < 2; ++mi)
#pragma unroll
      for (int ni = 0; ni < 2; ++ni) {
        const int n2 = col_b + ni * 32 - 2816;
        const int head = n2 >> 6, dv = n2 & 63;
#pragma unroll
        for (int jq = 0; jq < 4; ++jq) {
          const int row = row_b + mi * 32 + 8 * jq;
          int b, key;
          if (row < TL) { b = row >> 13; key = row & 8191; } else { b = (row - TL) >> 8; key = 8192 + ((row - TL) & 255); }
          u32x2 w;
          w[0] = pk_bf16(acc[mi][ni][4 * jq + 0], acc[mi][ni][4 * jq + 1]);
          w[1] = pk_bf16(acc[mi][ni][4 * jq + 2], acc[mi][ni][4 * jq + 3]);
          *(u32x2*)(VT + (size_t)((b * 8 + head) * 64 + dv) * NKEY + key) = w;
        }
      }
    return;
  }
  float* ct = (float*)smem;
#pragma unroll
  for (int mi = 0; mi < 2; ++mi)
#pragma unroll
    for (int ni = 0; ni < 2; ++ni) {
      const int col_l = wn * 64 + ni * 32 + r32;
      float bias = 0.f;
      if (epi == EPI_EW || epi == EPI_SIG) bias = g.bias[tn * 128 + col_l];
#pragma unroll
      for (int j = 0; j < 16; ++j) {
        const int row_l = wm * 64 + mi * 32 + (j & 3) + 8 * (j >> 2) + 4 * hh;
        float v = acc[mi][ni][j];
        if (epi == EPI_RELU2) { v = fmaxf(v, 0.f); v = v * v; }
        else if (epi == EPI_EW) v = -0.6065306597f * sigmoidf_(v + bias);
        else if (epi == EPI_SIG) v = sigmoidf_(v + bias);
        ct[row_l * 128 + col_l] = v;
      }
    }
  __syncthreads();
  {
    unsigned short* outp; int ldc, col0;
    if (epi == EPI_G1) {
      if (tn < 14) { outp = (unsigned short*)(p.ws + OFF_ZA); ldc = RC; col0 = tn * 128; }
      else { outp = (unsigned short*)(p.ws + OFF_QK); ldc = 1024; col0 = tn * 128 - RC; }
    } else { outp = (unsigned short*)g.out; ldc = g.ldc; col0 = tn * 128; }
    constexpr bool F16OUT = (epi == EPI_EW || epi == EPI_SIG || epi == EPI_F16);
#pragma unroll
    for (int i = 0; i < 8; ++i) {
      const int q = tid + 256 * i, row_l = q >> 4, cc = (q & 15) * 8;
      const f32x4 v0 = *(const f32x4*)(ct + row_l * 128 + cc), v1 = *(const f32x4*)(ct + row_l * 128 + cc + 4);
      u32x4 w;
      if (F16OUT) {
        f16x8 h;
        h[0] = (f16_t)v0[0]; h[1] = (f16_t)v0[1]; h[2] = (f16_t)v0[2]; h[3] = (f16_t)v0[3];
        h[4] = (f16_t)v1[0]; h[5] = (f16_t)v1[1]; h[6] = (f16_t)v1[2]; h[7] = (f16_t)v1[3];
        w = __builtin_bit_cast(u32x4, h);
      } else {
        w[0] = pk_bf16(v0[0], v0[1]); w[1] = pk_bf16(v0[2], v0[3]); w[2] = pk_bf16(v1[0], v1[1]); w[3] = pk_bf16(v1[2], v1[3]);
      }
      __builtin_nontemporal_store(w, (u32x4*)(outp + (size_t)(tm * 128 + row_l) * ldc + col0 + cc));
    }
  }
  __syncthreads();
}
struct Place { int xcc, rank, swz, scanpref; };
template <int EPI> DEVI void gemm_run(const Params& p, const GemmJob& g, unsigned char* smem, const Place& pl) {
  const int nm = g.M >> 7, nn = g.N >> 7;
  if (pl.swz) {
    const int nsn = nn >> 3, nn8 = nsn << 3, nsm = (nm + 7) >> 3;
    const int lm = pl.rank >> 3, ln = pl.rank & 7;
    for (int sid = pl.xcc; sid < nsm * nsn; sid += 8) {
      const int sm = sid / nsn, sn = sid - sm * nsn;
      const int tm = sm * 8 + lm, tn = sn * 8 + ln;
      if (tm < nm) gemm_tile<EPI>(p, g, tm, tn, smem);
    }
    const int rem = nn - nn8;
    for (int t = blockIdx.x; t < nm * rem; t += gridDim.x) gemm_tile<EPI>(p, g, t / rem, nn8 + t % rem, smem);
  } else {
    for (int t = blockIdx.x; t < nm * nn; t += gridDim.x) gemm_tile<EPI>(p, g, t / nn, t % nn, smem);
  }
}

DEVI void modvec_item(const Params& p, int item, unsigned char* smem) {
  const int l = item / 96, chunk = item % 96, tid = get_tid();
  float* sc = (float*)smem;
  float* red = (float*)(smem + 20480);
  for (int i = tid; i < 5 * 1024; i += 256) {
    const int b = i >> 10, k = i & 1023;
    const float v = b < 4 ? p.c[b * 1024 + k] : p.c_ctx[k];
    sc[i] = v * sigmoidf_(v);
  }
  __syncthreads();
  const int col = tid & 63, kg = tid >> 6;
  const float* w = p.ada_w + (size_t)l * 1024 * 6144 + chunk * 64 + col;
  float a0 = 0, a1 = 0, a2 = 0, a3 = 0, a4 = 0;
#pragma unroll 8
  for (int k = kg * 256; k < kg * 256 + 256; ++k) {
    const float wv = __builtin_nontemporal_load(w + (size_t)k * 6144);
    a0 += sc[k] * wv; a1 += sc[1024 + k] * wv; a2 += sc[2048 + k] * wv; a3 += sc[3072 + k] * wv; a4 += sc[4096 + k] * wv;
  }
  red[(kg * 5 + 0) * 64 + col] = a0; red[(kg * 5 + 1) * 64 + col] = a1; red[(kg * 5 + 2) * 64 + col] = a2;
  red[(kg * 5 + 3) * 64 + col] = a3; red[(kg * 5 + 4) * 64 + col] = a4;
  __syncthreads();
  float* MOD = (float*)(p.ws + OFF_MOD);
  for (int i = tid; i < 5 * 64; i += 256) {
    const int b = i >> 6, cc = i & 63;
    const float s = red[(0 * 5 + b) * 64 + cc] + red[(1 * 5 + b) * 64 + cc] + red[(2 * 5 + b) * 64 + cc] + red[(3 * 5 + b) * 64 + cc];
    const int gc = chunk * 64 + cc;
    MOD[(size_t)(l * 5 + b) * 6144 + gc] = s + p.ada_b[l * 6144 + gc];
  }
  __syncthreads();
}

DEVI void phase_setup(const Params& p, unsigned char* smem) {
  const int tid = get_tid();
  if (blockIdx.x == 0) {
    if (tid < 64) ((int*)(p.ws + OFF_CTR))[tid] = 0;
  }
  if (blockIdx.x == (gridDim.x > 1 ? 1 : 0)) {
    float2* RT = (float2*)(p.ws + OFF_ROPE);
    for (int i = tid; i < 1024; i += 256) {
      const int pos = i >> 3, f = i & 7;
      const float invf[8] = {1.0f, 0.31622776601683794f, 0.1f, 0.03162277660168379f, 0.01f, 0.003162277660168379f, 0.001f, 0.00031622776601683794f};
      float fr = 1.0f;
#pragma unroll
      for (int q = 0; q < 8; ++q) if (f == q) fr = invf[q];
      const float ang = (float)pos * fr;
      const double rev = (double)ang * 0.15915494309189535;
      const float fx = (float)(rev - floor(rev));
      RT[i] = make_float2(__builtin_amdgcn_cosf(fx), __builtin_amdgcn_sinf(fx));
    }
  }
  for (int it = blockIdx.x; it < DEPTH * 96; it += gridDim.x) modvec_item(p, it, smem);
  for (int it = blockIdx.x; it < DEPTH * 48; it += gridDim.x) {
    const int l = it / 48, r = it % 48;
    bf16_t* LW = (bf16_t*)(p.ws + OFF_LW) + (size_t)l * 196608;
    if (r < 32) {
      const int m = r >> 3, t = r & 7;
      const float* src = (m < 2 ? p.w_b : p.a_b) + (size_t)(l * 2 + (m & 1)) * 64 * 512;
      convert_tile(src, 64, 512, LW + m * 32768, 0, t, smem);
    } else {
      const int t = r - 32;
      convert_tile(p.g_b + (size_t)l * 128 * 512, 128, 512, LW + 131072, t >> 3, t & 7, smem);
    }
  }
  convert_matrix(p.w_in, 1024, INC, (bf16_t*)(p.ws + OFF_W), smem);
}

DEVI void rowpass(const Params& p, int mode, int l) {
  const int tid = get_tid(), lane = tid & 63, wave = tid >> 6;
  const int nrows = (l == DEPTH - 1 && mode >= 1) ? TL : NT;
  const float* MOD = (const float*)(p.ws + OFF_MOD);
  const bool from_in = (mode == 0 || (mode == 1 && l == 0));
  const int stride = gridDim.x * 4;
  f32x4 xv[4], fv[4], nxv[4], nfv[4];
#define RP_LOAD(XV, FV, r_)                                                                        \
  { const float* xs_ = from_in ? xin_row(p, (r_)) : xrow(p, (r_));                                 \
    _Pragma("unroll") for (int j = 0; j < 4; ++j) XV[j] = __builtin_nontemporal_load((const f32x4*)(xs_ + j * 256 + lane * 4)); \
    if (mode != 0) { const bf16_t* F_ = (const bf16_t*)(p.ws + OFF_F) + (size_t)(r_) * 1024;        \
      _Pragma("unroll") for (int j = 0; j < 4; ++j) { const u32x2 w_ = __builtin_nontemporal_load((const u32x2*)(F_ + j * 256 + lane * 4)); \
        FV[j][0] = bflo(w_[0]); FV[j][1] = bfhi(w_[0]); FV[j][2] = bflo(w_[1]); FV[j][3] = bfhi(w_[1]); } } }
#pragma unroll
  for (int j = 0; j < 4; ++j) { fv[j] = (f32x4){0.f, 0.f, 0.f, 0.f}; nfv[j] = fv[j]; nxv[j] = fv[j]; xv[j] = fv[j]; }
  int row = blockIdx.x * 4 + wave;
  if (row < nrows) RP_LOAD(xv, fv, row);
  for (; row < nrows; row += stride) {
    const int mi = mod_idx(row);
    if (row + stride < nrows) RP_LOAD(nxv, nfv, row + stride);
    if (mode != 0) {
      float ss = 0.f;
#pragma unroll
      for (int j = 0; j < 4; ++j) ss += fv[j][0] * fv[j][0] + fv[j][1] * fv[j][1] + fv[j][2] * fv[j][2] + fv[j][3] * fv[j][3];
      ss = wave_sum(ss);
      const float rstd = rsqrtf(ss * (1.0f / 1024.0f) + 1e-6f);
      const float* gpost = (mode == 1 ? p.g_post_mix : p.g_post_mlp) + l * 1024;
      const float* gate = MOD + (size_t)((l * 5 + mi) * 6 + (mode == 1 ? 2 : 5)) * 1024;
      float* xd = xrow(p, row);
#pragma unroll
      for (int j = 0; j < 4; ++j) {
        const f32x4 gp = *(const f32x4*)(gpost + j * 256 + lane * 4);
        const f32x4 gt = *(const f32x4*)(gate + j * 256 + lane * 4);
        xv[j] = xv[j] + gt * (fv[j] * rstd * gp);
        __builtin_nontemporal_store(xv[j], (f32x4*)(xd + j * 256 + lane * 4));
      }
    }
    if (!(mode == 2 && l == DEPTH - 1)) {
      const int l2 = (mode == 2) ? l + 1 : l;
      const float* gpre = (mode == 1 ? p.g_pre_mlp : p.g_pre_mix) + l2 * 1024;
      const float* sh = MOD + (size_t)((l2 * 5 + mi) * 6 + (mode == 1 ? 3 : 0)) * 1024;
      const float* sc = sh + 1024;
      float ss = 0.f;
#pragma unroll
      for (int j = 0; j < 4; ++j) ss += xv[j][0] * xv[j][0] + xv[j][1] * xv[j][1] + xv[j][2] * xv[j][2] + xv[j][3] * xv[j][3];
      ss = wave_sum(ss);
      const float rstd = rsqrtf(ss * (1.0f / 1024.0f) + 1e-6f);
      bf16_t* H = (bf16_t*)(p.ws + OFF_H) + (size_t)row * 1024;
#pragma unroll
      for (int j = 0; j < 4; ++j) {
        const f32x4 gp = *(const f32x4*)(gpre + j * 256 + lane * 4);
        const f32x4 s1 = *(const f32x4*)(sc + j * 256 + lane * 4);
        const f32x4 s0 = *(const f32x4*)(sh + j * 256 + lane * 4);
        const f32x4 hv = (xv[j] * rstd * gp) * (1.0f + s1) + s0;
        u32x2 w;
        w[0] = pk_bf16(hv[0], hv[1]); w[1] = pk_bf16(hv[2], hv[3]);
        __builtin_nontemporal_store(w, (u32x2*)(H + j * 256 + lane * 4));
      }
    }
#pragma unroll
    for (int j = 0; j < 4; ++j) { xv[j] = nxv[j]; fv[j] = nfv[j]; }
  }
#undef RP_LOAD
}

DEVI void p1_shift(const Params& p, int l) {
  const bf16_t* ZA = (const bf16_t*)(p.ws + OFF_ZA);
  bf16_t* ZR = (bf16_t*)(p.ws + OFF_ZR);
  bf16_t* LA = (bf16_t*)(p.ws + OFF_LA);
  float* KN = (float*)(p.ws + OFF_KN);
  const float* mu = p.shift_mu + l * RC;
  const float* kkw = p.k_k + l * 512;
  const int total = NT * 224;
  for (int idx = blockIdx.x * 256 + get_tid(); idx < total; idx += gridDim.x * 256) {
    const int row = idx / 224, ch = idx - row * 224, col = ch * 8;
    int pos, len;
    if (row < TL) { pos = row & 8191; len = 8192; } else { pos = (row - TL) & 255; len = 256; }
    const bf16_t* zp = ZA + (size_t)row * RC + col;
    const u32x4 zc = *(const u32x4*)zp;
    u32x4 zl = {0, 0, 0, 0}, zn = {0, 0, 0, 0};
    if (pos > 0) zl = *(const u32x4*)(zp - RC);
    if (pos < len - 1) zn = *(const u32x4*)(zp + RC);
    const f32x4 m0 = *(const f32x4*)(mu + col), m1 = *(const f32x4*)(mu + col + 4);
    float zs[8];
#pragma unroll
    for (int j = 0; j < 4; ++j) {
      const float c0 = bflo(zc[j]), c1 = bfhi(zc[j]);
      const float n0 = 0.5f * (bflo(zl[j]) + bflo(zn[j])), n1 = 0.5f * (bfhi(zl[j]) + bfhi(zn[j]));
      const float mu0 = (2 * j < 4) ? m0[2 * j] : m1[2 * j - 4];
      const float mu1 = (2 * j + 1 < 4) ? m0[2 * j + 1] : m1[2 * j + 1 - 4];
      zs[2 * j] = c0 + mu0 * (n0 - c0);
      zs[2 * j + 1] = c1 + mu1 * (n1 - c1);
    }
    float ksq = 0.f;
    const bool isk = (col >= 512 && col < 1024);
    if (col < 1536) {
      u32x4 o;
#pragma unroll
      for (int j = 0; j < 4; ++j) o[j] = pk_bf16(zs[2 * j], zs[2 * j + 1]);
      __builtin_nontemporal_store(o, (u32x4*)(ZR + (size_t)row * 1536 + col));
      if (isk) {
        const f32x4 k0 = *(const f32x4*)(kkw + col - 512), k1 = *(const f32x4*)(kkw + col - 512 + 4);
#pragma unroll
        for (int j = 0; j < 4; ++j) { const float a = zs[j] * k0[j], b = zs[4 + j] * k1[j]; ksq += a * a + b * b; }
      }
    } else {
      const int lc = col - 1536;
      float v[8];
#pragma unroll
      for (int j = 0; j < 8; ++j) {
        if (lc < 64) { const float e = __expf(2.0f * zs[j]); v[j] = 1.0f - 2.0f / (e + 1.0f); }
        else if (lc < 128) v[j] = zs[j];
        else v[j] = sigmoidf_(zs[j]);
      }
      u32x4 o;
#pragma unroll
      for (int j = 0; j < 4; ++j) o[j] = pk_bf16(v[2 * j], v[2 * j + 1]);
      __builtin_nontemporal_store(o, (u32x4*)(LA + (size_t)row * 256 + lc));
    }
    ksq += shfl_xor_(ksq, 1); ksq += shfl_xor_(ksq, 2); ksq += shfl_xor_(ksq, 4);
    if (isk && (ch & 7) == 0) KN[row * 8 + ((col - 512) >> 6)] = 1.0f / fmaxf(sqrtf(ksq), 1e-12f);
  }
}

DEVI void p1_rope(const Params& p) {
  bf16_t* QK = (bf16_t*)(p.ws + OFF_QK);
  const float2* RT = (const float2*)(p.ws + OFF_ROPE);
  const float qs = 0.17677669529663687f * 1.4426950408889634f;
  const int total = NT * 64;
  for (int idx = blockIdx.x * 256 + get_tid(); idx < total; idx += gridDim.x * 256) {
    const int row = idx >> 6, u = idx & 63, col = u * 16;
    const bool isq = col < 512;
    if (row >= TL && !isq) continue;
    bf16_t* ptr = QK + (size_t)row * 1024 + col;
    const u32x4 a = *(const u32x4*)ptr, b = *(const u32x4*)(ptr + 8);
    float x1[8], x2[8];
#pragma unroll
    for (int j = 0; j < 4; ++j) { x1[2 * j] = bflo(a[j]); x1[2 * j + 1] = bfhi(a[j]); x2[2 * j] = bflo(b[j]); x2[2 * j + 1] = bfhi(b[j]); }
    if (row < TL) {
      const int t = row & 8191;
      const int pos = (u & 1) ? (t & 63) : (t >> 6);
#pragma unroll
      for (int i = 0; i < 8; ++i) {
        const float2 cs = RT[pos * 8 + i];
        const float o1 = x1[i] * cs.x - x2[i] * cs.y, o2 = x1[i] * cs.y + x2[i] * cs.x;
        x1[i] = o1; x2[i] = o2;
      }
    }
    if (isq) {
#pragma unroll
      for (int i = 0; i < 8; ++i) { x1[i] *= qs; x2[i] *= qs; }
    }
    u32x4 oa, ob;
#pragma unroll
    for (int j = 0; j < 4; ++j) { oa[j] = pk_bf16(x1[2 * j], x1[2 * j + 1]); ob[j] = pk_bf16(x2[2 * j], x2[2 * j + 1]); }
    *(u32x4*)ptr = oa;
    *(u32x4*)(ptr + 8) = ob;
  }
}

typedef float f32x2 __attribute__((ext_vector_type(2)));
struct ScOp { f32x4 w, kk, nb, km, r; float v; };
DEVI void sc_ld(ScOp& o, const float* tb, const float* vp) {
  o.w = *(const f32x4*)tb; o.kk = *(const f32x4*)(tb + 64); o.nb = *(const f32x4*)(tb + 128);
  o.km = *(const f32x4*)(tb + 192); o.r = *(const f32x4*)(tb + 256); o.v = *vp;
}
constexpr int SC_TOK = 16, SC_STRIDE = 336;
struct ScRaw { u32x2 gr, gk, gv; f16x4 gew, ga; float gkn; };
DEVI void scan_item(const Params& p, int l, int item, unsigned char* smem) {
  const int tid = get_tid(), lane = tid & 63, wave = tid >> 6;
  const int rg = item & 3, dir = (item >> 2) & 1, h = (item >> 3) & 7, b = item >> 6;
  const int rl = lane >> 4, kl = lane & 15;
  float* IN = (float*)smem;
  float* YB = (float*)(smem + 2 * SC_TOK * SC_STRIDE * 4);
  const bf16_t* ZR = (const bf16_t*)(p.ws + OFF_ZR);
  const f16_t* EW = (const f16_t*)(p.ws + OFF_EW) + (size_t)dir * NT * 512;
  const f16_t* AA = (const f16_t*)(p.ws + OFF_AA) + (size_t)dir * NT * 512;
  const float* KN = (const float*)(p.ws + OFF_KN);
  f16_t* Y = (f16_t*)(p.ws + OFF_Y) + (size_t)dir * NT * 512;
  const int tl = tid >> 4, cg4 = (tid & 15) * 4;
  const f32x4 kkc = *(const f32x4*)(p.k_k + l * 512 + h * 64 + cg4);
  const f32x4 kac = *(const f32x4*)(p.k_a + l * 512 + h * 64 + cg4);
  ScRaw RA, RB;
  RA.gv[0] = 0; RA.gv[1] = 0; RB.gv[0] = 0; RB.gv[1] = 0;
#define SC_ROW(s, rowvar)                                                        \
  {                                                                              \
    int s_ = (s);                                                                \
    if (s_ < 256) rowvar = TL + b * 256 + (dir ? 255 - s_ : s_);                 \
    else { s_ -= 256; rowvar = b * 8192 + (dir ? 8191 - s_ : s_); }              \
  }
#define SC_LOAD(c, R)                                                            \
  {                                                                              \
    int row; SC_ROW((c) * SC_TOK + tl, row);                                     \
    const bf16_t* zr = ZR + (size_t)row * 1536 + h * 64 + cg4;                   \
    R.gr = *(const u32x2*)zr; R.gk = *(const u32x2*)(zr + 512);                  \
    if (cg4 < 16) R.gv = *(const u32x2*)(ZR + (size_t)row * 1536 + 1024 + h * 64 + rg * 16 + cg4); \
    R.gew = *(const f16x4*)(EW + (size_t)row * 512 + h * 64 + cg4);              \
    R.ga = *(const f16x4*)(AA + (size_t)row * 512 + h * 64 + cg4);               \
    R.gkn = KN[row * 8 + h];                                                     \
  }
#define SC_STAGE(buf, R)                                                         \
  {                                                                              \
    float* dst = IN + ((buf) * SC_TOK + tl) * SC_STRIDE + cg4;                   \
    const float kf[4] = {bflo(R.gk[0]), bfhi(R.gk[0]), bflo(R.gk[1]), bfhi(R.gk[1])}; \
    f32x4 w4, kk4, b4, km4, r4;                                                  \
    r4[0] = bflo(R.gr[0]); r4[1] = bfhi(R.gr[0]); r4[2] = bflo(R.gr[1]); r4[3] = bfhi(R.gr[1]); \
    _Pragma("unroll") for (int j = 0; j < 4; ++j) {                              \
      const float a = (float)R.ga[j];                                            \
      w4[j] = __expf((float)R.gew[j]);                                           \
      kk4[j] = kf[j] * kkc[j] * R.gkn;                                           \
      b4[j] = -kk4[j] * a;                                                       \
      km4[j] = kf[j] * (1.0f + (a - 1.0f) * kac[j]);                             \
    }                                                                            \
    *(f32x4*)(dst) = w4; *(f32x4*)(dst + 64) = kk4; *(f32x4*)(dst + 128) = b4;   \
    *(f32x4*)(dst + 192) = km4; *(f32x4*)(dst + 256) = r4;                       \
    if (cg4 < 16) {                                                              \
      f32x4 v4; v4[0] = bflo(R.gv[0]); v4[1] = bfhi(R.gv[0]); v4[2] = bflo(R.gv[1]); v4[3] = bfhi(R.gv[1]); \
      *(f32x4*)(IN + ((buf) * SC_TOK + tl) * SC_STRIDE + 320 + cg4) = v4;        \
    }                                                                            \
  }
#define SC_STEP(J)                                                                                            \
    {                                                                                                         \
      if ((J) + 2 < SC_TOK) sc_ld(ops[((J) + 2) % 3], in + ((J) + 2) * SC_STRIDE + kl * 4, in + ((J) + 2) * SC_STRIDE + vidx); \
      const ScOp& o = ops[(J) % 3];                                                                           \
      f32x2 pa = S01 * o.kk.xy;                                                                               \
      pa = S23 * o.kk.zw + pa;                                                                                \
      float sa = pa.x + pa.y;                                                                                 \
      const f32x2 vv = {o.v, o.v};                                                                            \
      f32x2 t01 = vv * o.km.xy, t23 = vv * o.km.zw;                                                           \
      t01 = S01 * o.w.xy + t01;                                                                               \
      t23 = S23 * o.w.zw + t23;                                                                               \
      sa = allreduce16(sa);                                                                                   \
      const f32x2 sv = {sa, sa};                                                                              \
      S01 = sv * o.nb.xy + t01;                                                                               \
      S23 = sv * o.nb.zw + t23;                                                                               \
      f32x2 py = S01 * o.r.xy;                                                                                \
      py = S23 * o.r.zw + py;                                                                                 \
      yp[J] = py.x + py.y;     \
    }
#define SC_CHUNK(BUF)                                                                                         \
    {                                                                                                         \
      const float* in = IN + (BUF) * SC_TOK * SC_STRIDE;                                                      \
      ScOp ops[3];                                                                                            \
      sc_ld(ops[0], in + kl * 4, in + vidx);                                                                  \
      sc_ld(ops[1], in + SC_STRIDE + kl * 4, in + SC_STRIDE + vidx);                                          \
      float yp[16];                                                                                           \
      SC_STEP(0) SC_STEP(1) SC_STEP(2) SC_STEP(3) SC_STEP(4) SC_STEP(5) SC_STEP(6) SC_STEP(7)                 \
      SC_STEP(8) SC_STEP(9) SC_STEP(10) SC_STEP(11) SC_STEP(12) SC_STEP(13) SC_STEP(14) SC_STEP(15)           \
        \
      float ya[8], yb4[4], yc[2];                                                                             \
      _Pragma("unroll") for (int i = 0; i < 8; ++i) {                                                         \
        const float keep = bit3 ? yp[i + 8] : yp[i], send = bit3 ? yp[i] : yp[i + 8];                         \
        ya[i] = keep + dpp_get<0x128>(send);                                         \
      }                                                                                                       \
      _Pragma("unroll") for (int i = 0; i < 4; ++i) {                                                         \
        const float keep = bit2 ? ya[i + 4] : ya[i], send = bit2 ? ya[i] : ya[i + 4];                         \
        yb4[i] = keep + dpp_get<0x141>(send);                                  \
      }                                                                                                       \
      _Pragma("unroll") for (int i = 0; i < 2; ++i) {                                                         \
        const float keep = bit1 ? yb4[i + 2] : yb4[i], send = bit1 ? yb4[i] : yb4[i + 2];                     \
        yc[i] = keep + dpp_get<0x4E>(send);                                \
      }                                                                                                       \
      const float ykeep = bit0 ? yc[1] : yc[0], ysend = bit0 ? yc[0] : yc[1];                                 \
      const float ysel = ykeep + dpp_get<0xB1>(ysend);                     \
      YB[(BUF) * 256 + kl * 16 + wave * 4 + rl] = ysel;                                                       \
    }
#define SC_YOUT(c, BUF)                                                                                       \
    {                                                                                                         \
      int row; SC_ROW((c) * SC_TOK + (tid >> 4), row);                                                        \
      Y[(size_t)row * 512 + h * 64 + rg * 16 + (tid & 15)] = (f16_t)(YB[(BUF) * 256 + tid] * 0.0625f);       \
    }
  constexpr int NCH = NKEY / SC_TOK;
  SC_LOAD(0, RA);
  SC_LOAD(1, RB);
  SC_STAGE(0, RA);
  __syncthreads();
  f32x2 S01 = {0.f, 0.f}, S23 = {0.f, 0.f};
  const int vidx = 320 + wave * 4 + rl;
  const bool bit3 = (kl & 8) != 0, bit2 = (kl & 4) != 0, bit1 = (kl & 2) != 0, bit0 = (kl & 1) != 0;
  __builtin_amdgcn_s_setprio(3);
  for (int c = 0; c < NCH; c += 2) {
    const bool more = (c + 2 < NCH);
    if (more) SC_LOAD(c + 2, RA);
    SC_CHUNK(0);
    SC_STAGE(1, RB);
    __syncthreads();
    SC_YOUT(c, 0);
    if (more) SC_LOAD(c + 3, RB);
    SC_CHUNK(1);
    if (more) SC_STAGE(0, RA);
    __syncthreads();
    SC_YOUT(c + 1, 1);
  }
  __builtin_amdgcn_s_setprio(0);
  __syncthreads();
#undef SC_ROW
#undef SC_LOAD
#undef SC_STAGE
#undef SC_STEP
#undef SC_CHUNK
#undef SC_YOUT
}

constexpr int AT_KB = 8192, AT_VB = 64 * 136;
template <bool SHIFT> DEVI void attn_body(const Params& p, int l, int idx, unsigned char* smem, float lam, float lam_init) {
  const int tid = get_tid(), lane = tid & 63, wave = tid >> 6, r32 = lane & 31, hh = lane >> 5;
  int b, h, qrow0, kt0, kt1;
  if (idx < 2048) { const int bh = idx >> 6, qb = idx & 63; b = bh >> 3; h = bh & 7; qrow0 = b * 8192 + qb * 128; kt0 = 0; kt1 = 132; }
  else { const int j = idx - 2048, bh = j >> 1, qb = j & 1; b = bh >> 3; h = bh & 7; qrow0 = TL + b * 256 + qb * 128; kt0 = 128; kt1 = 132; }
  const bf16_t* QK = (const bf16_t*)(p.ws + OFF_QK);
  const bf16_t* VT = (const bf16_t*)(p.ws + OFF_VT) + (size_t)(b * 8 + h) * 64 * NKEY;
  unsigned char* KB = smem;
  unsigned char* VB = smem + 2 * AT_KB;
  bf16x8 qf[2][2];
  {
    const bf16_t* qp = QK + (size_t)(qrow0 + wave * 32 + r32) * 1024 + h * 64 + hh * 8;
#pragma unroll
    for (int s = 0; s < 2; ++s)
#pragma unroll
      for (int ks = 0; ks < 2; ++ks) qf[s][ks] = *(const bf16x8*)(qp + s * 32 + ks * 16);
  }
  const int lkey = tid >> 2, lc0 = (tid & 3) * 2;
  u32x4 rk0, rk1, rv0, rv1;
#define AT_LOAD(kt)                                                                           \
  {                                                                                           \
    const int kx = (kt) * 64 + lkey;                                                          \
    const int krow = kx < 8192 ? b * 8192 + kx : TL + b * 256 + (kx - 8192);                  \
    const bf16_t* kp = QK + (size_t)krow * 1024 + 512 + h * 64 + lc0 * 8;                     \
    rk0 = *(const u32x4*)kp; rk1 = *(const u32x4*)(kp + 8);                                   \
    const bf16_t* vp = VT + (size_t)lkey * NKEY + (kt) * 64 + lc0 * 8;                        \
    rv0 = *(const u32x4*)vp; rv1 = *(const u32x4*)(vp + 8);                                   \
  }
#define AT_STORE(buf)                                                                         \
  {                                                                                           \
    unsigned char* kb = KB + (buf) * AT_KB + lkey * 128;                                      \
    const int sw = (lkey >> 1) & 7;                                                           \
    *(u32x4*)(kb + ((lc0 ^ sw) << 4)) = rk0;                                                  \
    *(u32x4*)(kb + (((lc0 + 1) ^ sw) << 4)) = rk1;                                            \
    unsigned char* vb = VB + (buf) * AT_VB + lkey * 136 + lc0 * 16;                           \
    u32x2 t;                                                                                  \
    t[0] = rv0[0]; t[1] = rv0[1]; *(u32x2*)(vb) = t;                                          \
    t[0] = rv0[2]; t[1] = rv0[3]; *(u32x2*)(vb + 8) = t;                                      \
    t[0] = rv1[0]; t[1] = rv1[1]; *(u32x2*)(vb + 16) = t;                                     \
    t[0] = rv1[2]; t[1] = rv1[3]; *(u32x2*)(vb + 24) = t;                                     \
  }
  f32x16 O[2][2];
#pragma unroll
  for (int s = 0; s < 2; ++s)
#pragma unroll
    for (int d = 0; d < 2; ++d)
#pragma unroll
      for (int e = 0; e < 16; ++e) O[s][d][e] = 0.f;
  float mref[2];
  f32x2 lacc[2];
  int need = 0;
  {
    const float* KM = (const float*)(p.ws + OFF_KM);
#pragma unroll
    for (int s = 0; s < 2; ++s) {
      float ss = 0.f;
#pragma unroll
      for (int ks = 0; ks < 2; ++ks)
#pragma unroll
        for (int j = 0; j < 8; ++j) { const float v = __uint_as_float(((unsigned)(unsigned short)qf[s][ks][j]) << 16); ss += v * v; }
      ss += shfl_xor_(ss, 32);
      mref[s] = sqrtf(ss * KM[(b * 8 + h) * 2 + s]);
      need |= (mref[s] > 96.0f) ? 1 : 0;
      lacc[s] = (f32x2){0.f, 0.f};
    }
  }
  (void)need;
  const f32x16 zero16 = {0.f, 0.f, 0.f, 0.f, 0.f, 0.f, 0.f, 0.f, 0.f, 0.f, 0.f, 0.f, 0.f, 0.f, 0.f, 0.f};
  AT_LOAD(kt0);
  AT_STORE(0);
  __syncthreads();
  for (int kt = kt0; kt < kt1; ++kt) {
    const int buf = (kt - kt0) & 1;
    const bool more = (kt + 1 < kt1);
    if (more) AT_LOAD(kt + 1);
    const unsigned char* kb = KB + buf * AT_KB;
    const unsigned char* vb = VB + buf * AT_VB;
#define AT_QK(S_, KB_, SC)                                                                                      \
    {                                                                                                           \
      const int key = (KB_) * 32 + r32;                                                                         \
      const bf16x8 kf0 = *(const bf16x8*)(kb + key * 128 + ((((S_) * 4 + hh) ^ ((key >> 1) & 7)) << 4));         \
      const bf16x8 kf1 = *(const bf16x8*)(kb + key * 128 + ((((S_) * 4 + 2 + hh) ^ ((key >> 1) & 7)) << 4));     \
      SC = __builtin_amdgcn_mfma_f32_32x32x16_bf16(kf0, qf[S_][0], zero16, 0, 0, 0);                            \
      SC = __builtin_amdgcn_mfma_f32_32x32x16_bf16(kf1, qf[S_][1], SC, 0, 0, 0);                                \
    }
#define AT_SPV(S_, KB_, SC)                                                                                     \
    {                                                                                                           \
      if (SHIFT) { _Pragma("unroll") for (int e = 0; e < 16; ++e) SC[e] -= mref[S_]; }                          \
      _Pragma("unroll") for (int e = 0; e < 16; ++e) SC[e] = __builtin_amdgcn_exp2f(SC[e]);                     \
      _Pragma("unroll") for (int e = 0; e < 8; ++e) lacc[S_] += (f32x2){SC[2 * e], SC[2 * e + 1]};              \
      _Pragma("unroll") for (int s2 = 0; s2 < 2; ++s2) {                                                        \
        u32x4 w;                                                                                                \
        w[0] = pk_bf16(SC[8 * s2 + 0], SC[8 * s2 + 1]); w[1] = pk_bf16(SC[8 * s2 + 2], SC[8 * s2 + 3]);         \
        w[2] = pk_bf16(SC[8 * s2 + 4], SC[8 * s2 + 5]); w[3] = pk_bf16(SC[8 * s2 + 6], SC[8 * s2 + 7]);         \
        const bf16x8 pf = __builtin_bit_cast(bf16x8, w);                                                        \
        _Pragma("unroll") for (int d = 0; d < 2; ++d) {                                                         \
          const unsigned char* vp = vb + (d * 32 + r32) * 136 + ((KB_) * 32 + 16 * s2 + 4 * hh) * 2;            \
          const u32x2 v0 = *(const u32x2*)vp, v1 = *(const u32x2*)(vp + 16);                                    \
          u32x4 vv; vv[0] = v0[0]; vv[1] = v0[1]; vv[2] = v1[0]; vv[3] = v1[1];                                 \
          const bf16x8 vf = __builtin_bit_cast(bf16x8, vv);                                                     \
          O[S_][d] = __builtin_amdgcn_mfma_f32_32x32x16_bf16(vf, pf, O[S_][d], 0, 0, 0);                        \
        }                                                                                                       \
      }                                                                                                         \
    }
    {
      f32x16 scA, scB;
      AT_QK(0, 0, scA);
      AT_QK(0, 1, scB);
      AT_SPV(0, 0, scA);
      AT_QK(1, 0, scA);
      AT_SPV(0, 1, scB);
      AT_QK(1, 1, scB);
      AT_SPV(1, 0, scA);
      AT_SPV(1, 1, scB);
    }
#undef AT_QK
#undef AT_SPV
    if (more) AT_STORE(buf ^ 1);
    __syncthreads();
  }
  float l1 = lacc[0].x + lacc[0].y, l2 = lacc[1].x + lacc[1].y;
  l1 += shfl_xor_(l1, 32); l2 += shfl_xor_(l2, 32);
  const float i1 = 1.0f / l1, i2 = lam / l2;
  float ss = 0.f;
#pragma unroll
  for (int d = 0; d < 2; ++d)
#pragma unroll
    for (int e = 0; e < 16; ++e) { const float o = O[0][d][e] * i1 - O[1][d][e] * i2; O[0][d][e] = o; ss += o * o; }
  ss += shfl_xor_(ss, 32);
  const float rstd = rsqrtf(ss * (1.0f / 64.0f) + 1e-5f) * (1.0f - lam_init);
  bf16_t* Oo = (bf16_t*)(p.ws + OFF_H) + (size_t)(qrow0 + wave * 32 + r32) * 1024 + 512 + h * 64;
  const float* sg = p.subln_g + l * 64;
#pragma unroll
  for (int d = 0; d < 2; ++d)
#pragma unroll
    for (int jq = 0; jq < 4; ++jq) {
      const int dv = d * 32 + 8 * jq + 4 * hh;
      const f32x4 g4 = *(const f32x4*)(sg + dv);
      u32x2 w;
      w[0] = pk_bf16(O[0][d][4 * jq + 0] * rstd * g4[0], O[0][d][4 * jq + 1] * rstd * g4[1]);
      w[1] = pk_bf16(O[0][d][4 * jq + 2] * rstd * g4[2], O[0][d][4 * jq + 3] * rstd * g4[3]);
      *(u32x2*)(Oo + dv) = w;
    }
#undef AT_LOAD
#undef AT_STORE
}

DEVI void attn_item(const Params& p, int l, int idx, unsigned char* smem, float lam, float lam_init) {
  const int tid = get_tid(), lane = tid & 63, wave = tid >> 6, r32 = lane & 31, hh = lane >> 5;
  int b, h, qrow0;
  if (idx < 2048) { const int bh = idx >> 6, qb = idx & 63; b = bh >> 3; h = bh & 7; qrow0 = b * 8192 + qb * 128; }
  else { const int j = idx - 2048, bh = j >> 1, qb = j & 1; b = bh >> 3; h = bh & 7; qrow0 = TL + b * 256 + qb * 128; }
  const bf16_t* qp = (const bf16_t*)(p.ws + OFF_QK) + (size_t)(qrow0 + wave * 32 + r32) * 1024 + h * 64 + hh * 8;
  const float* KM = (const float*)(p.ws + OFF_KM);
  int need = 0;
#pragma unroll
  for (int s = 0; s < 2; ++s) {
    float ss = 0.f;
#pragma unroll
    for (int ks = 0; ks < 2; ++ks) {
      const u32x4 v = *(const u32x4*)(qp + s * 32 + ks * 16);
#pragma unroll
      for (int j = 0; j < 4; ++j) { const float a = bflo(v[j]), c = bfhi(v[j]); ss += a * a + c * c; }
    }
    ss += shfl_xor_(ss, 32);
    need |= (sqrtf(ss * KM[(b * 8 + h) * 2 + s]) > 96.0f) ? 1 : 0;
  }
  need = __syncthreads_or(need);
  if (need) attn_body<true>(p, l, idx, smem, lam, lam_init);
  else attn_body<false>(p, l, idx, smem, lam, lam_init);
}

DEVI void kmax_job(const Params& p, unsigned char* smem) {
  const int tid = get_tid();
  const bf16_t* QK = (const bf16_t*)(p.ws + OFF_QK);
  float* red = (float*)smem;
  for (int item = blockIdx.x; item < NB * 16 * 8; item += gridDim.x) {
    const int bhs = item >> 3, chunk = item & 7, b = bhs >> 4, hs = bhs & 15;
    float mx = 0.f;
    for (int kx = chunk * 1056 + tid; kx < (chunk + 1) * 1056; kx += 256) {
      const int row = kx < 8192 ? b * 8192 + kx : TL + b * 256 + (kx - 8192);
      const bf16_t* kp = QK + (size_t)row * 1024 + 512 + hs * 32;
      float ss = 0.f;
#pragma unroll
      for (int c = 0; c < 4; ++c) {
        const u32x4 v = *(const u32x4*)(kp + c * 8);
#pragma unroll
        for (int j = 0; j < 4; ++j) { const float a = bflo(v[j]), bb = bfhi(v[j]); ss += a * a + bb * bb; }
      }
      mx = fmaxf(mx, ss);
    }
#pragma unroll
    for (int o = 32; o >= 1; o >>= 1) mx = fmaxf(mx, shfl_xor_(mx, o));
    if ((tid & 63) == 0) red[tid >> 6] = mx;
    __syncthreads();
    if (tid == 0) atomicMax((int*)(p.ws + OFF_KM) + bhs, __float_as_int(fmaxf(fmaxf(red[0], red[1]), fmaxf(red[2], red[3]))));
    __syncthreads();
  }
}

DEVI void phase_mixers(const Params& p, int l, unsigned char* smem, const Place& pl) {
  int* ctr = (int*)(p.ws + OFF_CTR) + l;
  int* s_item = (int*)(smem + 65536 - 16);
  const float lam_init = 0.8f - 0.6f * __expf(-0.3f * (float)l);
  float d1 = 0.f, d2 = 0.f;
  for (int i = 0; i < 32; ++i) { d1 += p.lam_q1[l * 32 + i] * p.lam_k1[l * 32 + i]; d2 += p.lam_q2[l * 32 + i] * p.lam_k2[l * 32 + i]; }
  const float lam = __expf(d1) - __expf(d2) + lam_init;
  const int nattn = 2048 + (l < DEPTH - 1 ? 64 : 0);
  int* ctr_s = ctr;
  int* ctr_a = ctr + 16;
  int mode = pl.scanpref ? 0 : 1;
  while (true) {
    if (get_tid() == 0) {
      int it = -1;
      if (mode == 0) { const int i = atomicAdd(ctr_s, 1); if (i < 256) it = i; else mode = 1; }
      if (it < 0 && mode == 1) { const int j = atomicAdd(ctr_a, 1); if (j < nattn) it = 256 + j; else mode = 2; }
      if (it < 0 && mode == 2) { const int i = atomicAdd(ctr_s, 1); if (i < 256) it = i; }
      s_item[0] = it; s_item[1] = mode;
    }
    __syncthreads();
    const int item = s_item[0];
    mode = s_item[1];
    __syncthreads();
    if (item < 0) break;
    if (item < 256) scan_item(p, l, item, smem);
    else attn_item(p, l, item - 256, smem, lam, lam_init);
  }
}

DEVI void finish(const Params& p, int l) {
  const int nrows = (l == DEPTH - 1) ? TL : NT;
  const f16_t* Y0 = (const f16_t*)(p.ws + OFF_Y);
  const f16_t* Y1 = Y0 + (size_t)NT * 512;
  const bf16_t* ZR = (const bf16_t*)(p.ws + OFF_ZR);
  const f16_t* GATE = (const f16_t*)(p.ws + OFF_GATE);
  bf16_t* Oo = (bf16_t*)(p.ws + OFF_H);
  const int total = nrows * 64;
  for (int idx = blockIdx.x * 256 + get_tid(); idx < total; idx += gridDim.x * 256) {
    const int row = idx >> 6, col = (idx & 63) * 8;
    const f16x8 y0 = __builtin_nontemporal_load((const f16x8*)(Y0 + (size_t)row * 512 + col)), y1 = __builtin_nontemporal_load((const f16x8*)(Y1 + (size_t)row * 512 + col));
    float y[8], s = 0.f;
#pragma unroll
    for (int j = 0; j < 8; ++j) { y[j] = ((float)y0[j] + (float)y1[j]) * 16.0f; s += y[j]; }
    s += shfl_xor_(s, 1); s += shfl_xor_(s, 2); s += shfl_xor_(s, 4);
    const float mu = s * (1.0f / 64.0f);
    float q = 0.f;
#pragma unroll
    for (int j = 0; j < 8; ++j) { y[j] -= mu; q += y[j] * y[j]; }
    q += shfl_xor_(q, 1); q += shfl_xor_(q, 2); q += shfl_xor_(q, 4);
    const float rstd = rsqrtf(q * (1.0f / 64.0f) + 64e-5f);
    const bf16_t* zr = ZR + (size_t)row * 1536 + col;
    const u32x4 ru = __builtin_nontemporal_load((const u32x4*)zr), ku = __builtin_nontemporal_load((const u32x4*)(zr + 512)), vu = __builtin_nontemporal_load((const u32x4*)(zr + 1024));
    float rf[8], kf[8], vf[8];
#pragma unroll
    for (int j = 0; j < 4; ++j) {
      rf[2 * j] = bflo(ru[j]); rf[2 * j + 1] = bfhi(ru[j]);
      kf[2 * j] = bflo(ku[j]); kf[2 * j + 1] = bfhi(ku[j]);
      vf[2 * j] = bflo(vu[j]); vf[2 * j + 1] = bfhi(vu[j]);
    }
    const float* rkp = p.r_k + l * 512 + col;
    const f32x4 rk0 = *(const f32x4*)rkp, rk1 = *(const f32x4*)(rkp + 4);
    float rk = 0.f;
#pragma unroll
    for (int j = 0; j < 4; ++j) rk += rf[j] * kf[j] * rk0[j] + rf[4 + j] * kf[4 + j] * rk1[j];
    rk += shfl_xor_(rk, 1); rk += shfl_xor_(rk, 2); rk += shfl_xor_(rk, 4);
    const f16x8 gt = __builtin_nontemporal_load((const f16x8*)(GATE + (size_t)row * 512 + col));
    const float* lg = p.lnx_g + l * 512 + col;
    const float* lb = p.lnx_b + l * 512 + col;
    const f32x4 g0 = *(const f32x4*)lg, g1 = *(const f32x4*)(lg + 4), b0 = *(const f32x4*)lb, b1 = *(const f32x4*)(lb + 4);
    float o[8];
#pragma unroll
    for (int j = 0; j < 8; ++j) {
      const float gg = j < 4 ? g0[j & 3] : g1[j & 3], bb = j < 4 ? b0[j & 3] : b1[j & 3];
      o[j] = ((y[j] * rstd * gg + bb) + rk * vf[j]) * (float)gt[j];
    }
    u32x4 w;
#pragma unroll
    for (int j = 0; j < 4; ++j) w[j] = pk_bf16(o[2 * j], o[2 * j + 1]);
    *(u32x4*)(Oo + (size_t)row * 1024 + col) = w;
  }
}

DEVI void run_phase(const Params& p, int ph, unsigned char* smem, const Place& pl) {
  if (ph == 0) { phase_setup(p, smem); return; }
  if (ph == 1) { rowpass(p, 0, 0); return; }
  const int l = (ph - 2) / 10, s = (ph - 2) % 10;
  const int nrows = (l == DEPTH - 1) ? TL : NT;
  bf16_t* W = (bf16_t*)(p.ws + OFF_W);
  GemmJob g;
  switch (s) {
    case 0:
      g.A = (const bf16_t*)(p.ws + OFF_H); g.lda = 1024; g.Bt = W; g.K = 1024; g.M = NT; g.N = INC; g.epi = EPI_G1;
      g.out = nullptr; g.ldc = 0; g.bias = nullptr;
      gemm_run<EPI_G1>(p, g, smem, pl);
      break;
    case 1:
      if (blockIdx.x == 0) { const int t_ = get_tid(); if (t_ < 64) ((int*)(p.ws + OFF_KM))[t_] = 0; }
      p1_shift(p, l);
      p1_rope(p);
      break;
    case 2: {
      const bf16_t* LW = (const bf16_t*)(p.ws + OFF_LW) + (size_t)l * 196608;
      const bf16_t* LA = (const bf16_t*)(p.ws + OFF_LA);
      kmax_job(p, smem);
      g.lda = 256; g.M = NT; g.N = 512; g.ldc = 512;
      for (int j = 0; j < 2; ++j) {
        g.A = LA; g.Bt = LW + j * 32768; g.K = 64; g.epi = EPI_EW; g.out = p.ws + OFF_EW + (size_t)j * SZ_T512x2; g.bias = p.w0 + (l * 2 + j) * 512;
        gemm_run<EPI_EW>(p, g, smem, pl);
      }
      for (int j = 0; j < 2; ++j) {
        g.A = LA + 64; g.Bt = LW + 65536 + j * 32768; g.K = 64; g.epi = EPI_SIG; g.out = p.ws + OFF_AA + (size_t)j * SZ_T512x2; g.bias = p.a0 + (l * 2 + j) * 512;
        gemm_run<EPI_SIG>(p, g, smem, pl);
      }
      g.A = LA + 128; g.Bt = LW + 131072; g.K = 128; g.epi = EPI_F16; g.out = p.ws + OFF_GATE; g.bias = nullptr;
      gemm_run<EPI_F16>(p, g, smem, pl);
      break;
    }
    case 3:
      phase_mixers(p, l, smem, pl);
      break;
    case 4:
      finish(p, l);
      convert_matrix(p.w_out + (size_t)l * 1024 * 1024, 1024, 1024, W, smem);
      convert_matrix(p.w_ff1 + (size_t)l * 1024 * 4096, 1024, 4096, W + 1024 * 1024, smem);
      convert_matrix(p.w_ff2 + (size_t)l * 4096 * 1024, 4096, 1024, W + 1024 * 1024 + 4096 * 1024, smem);
      break;
    case 5:
      g.A = (const bf16_t*)(p.ws + OFF_H); g.lda = 1024; g.Bt = W; g.K = 1024; g.M = nrows; g.N = 1024; g.epi = EPI_BF16;
      g.out = p.ws + OFF_F; g.ldc = 1024; g.bias = nullptr;
      gemm_run<EPI_BF16>(p, g, smem, pl);
      break;
    case 6:
      rowpass(p, 1, l);
      break;
    case 7:
      g.A = (const bf16_t*)(p.ws + OFF_H); g.lda = 1024; g.Bt = W + 1024 * 1024; g.K = 1024; g.M = nrows; g.N = 4096; g.epi = EPI_RELU2;
      g.out = p.ws + OFF_HID; g.ldc = 4096; g.bias = nullptr;
      gemm_run<EPI_RELU2>(p, g, smem, pl);
      break;
    case 8:
      g.A = (const bf16_t*)(p.ws + OFF_HID); g.lda = 4096; g.Bt = W + 1024 * 1024 + 4096 * 1024; g.K = 4096; g.M = nrows; g.N = 1024; g.epi = EPI_BF16;
      g.out = p.ws + OFF_F; g.ldc = 1024; g.bias = nullptr;
      gemm_run<EPI_BF16>(p, g, smem, pl);
      break;
    case 9:
      rowpass(p, 2, l);
      if (l + 1 < DEPTH) convert_matrix(p.w_in + (size_t)(l + 1) * 1024 * INC, 1024, INC, W, smem);
      break;
  }
}


#define XB_TMO      128
#define XB_XCNT(j)  (256  + 64 * (j))
#define XB_XSUB(j)  (1280 + 64 * (j))
#define XB_XGEN(j)  (2304 + 64 * (j))
#define XB_TOP      3328
#define XB_TOPGEN   3392
#define XB_PAR      192
#define XCD_BAR_WORDS 3456
#define XB_SPIN_CAP (1u << 22)
DEVI unsigned xb_ld(unsigned* p) { return __hip_atomic_load(p, __ATOMIC_RELAXED, __HIP_MEMORY_SCOPE_AGENT); }
DEVI unsigned xb_add(unsigned* p, unsigned v) { return __hip_atomic_fetch_add(p, v, __ATOMIC_RELAXED, __HIP_MEMORY_SCOPE_AGENT); }
DEVI unsigned xb_xcc_id() { return (unsigned)__builtin_amdgcn_s_getreg((3 << 11) | 20) & 0xFu; }
#define XB_SPIN(cond, bar) do { unsigned _sp = 0; while (cond) { __builtin_amdgcn_s_sleep(1); \
    if ((++_sp & 255u) == 0u) { if (xb_ld(&(bar)[XB_TMO])) break; if (_sp > XB_SPIN_CAP) { atomicAdd(&(bar)[XB_TMO], 1u); break; } } } } while (0)
DEVI void xcd_barrier(unsigned* bar, unsigned x, unsigned nloc, unsigned nx) {
  asm volatile("s_waitcnt vmcnt(0)" ::: "memory");
  __syncthreads();
  if (threadIdx.x == 0) {
    __builtin_amdgcn_s_waitcnt(0);
    const unsigned old = xb_add(&bar[XB_XSUB(x)], 1u);
    const unsigned gen = old / nloc;
    if (old + 1u == (gen + 1u) * nloc) {
      __builtin_amdgcn_fence(__ATOMIC_RELEASE, "agent");
      asm volatile("s_waitcnt vmcnt(0)" ::: "memory");
      const unsigned og = xb_add(&bar[XB_TOP], 1u);
      const unsigned tg = og / nx;
      if (og + 1u == (tg + 1u) * nx) xb_add(&bar[XB_TOPGEN], 1u);
      else XB_SPIN(xb_ld(&bar[XB_TOPGEN]) == tg, bar);
      __builtin_amdgcn_fence(__ATOMIC_ACQUIRE, "agent");
      xb_add(&bar[XB_XGEN(x)], 1u);
      asm volatile("s_waitcnt vmcnt(0)" ::: "memory");
    } else {
      XB_SPIN(xb_ld(&bar[XB_XGEN(x)]) == gen, bar);
      __builtin_amdgcn_fence(__ATOMIC_ACQUIRE, "agent");
      asm volatile("s_waitcnt vmcnt(0)" ::: "memory");
    }
  }
  __syncthreads();
}

__global__ void __launch_bounds__(256, 2) fwd_megakernel(Params p, int ph0, int ph1) {
  __shared__ __attribute__((aligned(16))) unsigned char smem[65536];
  cg::grid_group grid = cg::this_grid();
  unsigned* bar = (unsigned*)(p.ws + OFF_BAR);
  const unsigned xcc = xb_xcc_id();
  unsigned nloc = 1u, nx = 1u;
  const bool coop = (ph1 - ph0 > 1);
  Place pl; pl.xcc = (int)xcc; pl.rank = 0; pl.swz = 0; pl.scanpref = 1;
  const unsigned cu_par = ((unsigned)__builtin_amdgcn_s_getreg((15 << 11) | 4) >> 8) & 1u;
  if (coop) {
    if (threadIdx.x == 0 && cu_par) (void)xb_add(&bar[XB_PAR], 1u);
    if (threadIdx.x == 0) *(volatile unsigned*)smem = xb_add(&bar[XB_XCNT(xcc)], 1u);
    __syncthreads();
    pl.rank = __builtin_amdgcn_readfirstlane((int)*(volatile unsigned*)smem);
    __syncthreads();
  }
  for (int ph = ph0; ph < ph1; ++ph) {
    run_phase(p, ph, smem, pl);
    if (ph + 1 < ph1) {
      if (ph == ph0) {
        grid.sync();
        if (threadIdx.x == 0) {
          unsigned cnt = 0u, mine = 0u, ok = (gridDim.x == 512u) ? 1u : 0u;
#pragma unroll
          for (unsigned j = 0; j < 16; ++j) {
            const unsigned c = xb_ld(&bar[XB_XCNT(j)]);
            cnt += (c > 0u) ? 1u : 0u; mine = (j == xcc) ? c : mine;
            if (j < 8 ? (c != 64u) : (c != 0u)) ok = 0u;
          }
          nloc = mine > 0u ? mine : 1u; nx = cnt > 0u ? cnt : 1u;
          const unsigned n_odd = xb_ld(&bar[XB_PAR]), n_even = gridDim.x - n_odd;
          const unsigned scan_class = (n_even >= 256u) ? 0u : 1u;
          ((volatile unsigned*)smem)[0] = ok;
          ((volatile unsigned*)smem)[1] = (cu_par == scan_class) ? 1u : 0u;
        }
        __syncthreads();
        pl.swz = __builtin_amdgcn_readfirstlane((int)((volatile unsigned*)smem)[0]);
        pl.scanpref = __builtin_amdgcn_readfirstlane((int)((volatile unsigned*)smem)[1]);
        __syncthreads();
      } else {
        xcd_barrier(bar, xcc, nloc, nx);
      }
    }
  }
}

extern "C" void kernel_launch(void* const* d_in, const int* in_sizes, int n_in, void* d_out, int out_size,
                              void* d_ws, size_t ws_size, hipStream_t stream) {
  static int grid_blocks = 0;
  if (!grid_blocks) {
    int dev = 0, cus = 0, per_cu = 0;
    hipGetDevice(&dev);
    hipDeviceGetAttribute(&cus, hipDeviceAttributeMultiprocessorCount, dev);
    hipOccupancyMaxActiveBlocksPerMultiprocessor(&per_cu, fwd_megakernel, 256, 0);
    if (per_cu < 1) per_cu = 1;
    if (per_cu > 2) per_cu = 2;
    grid_blocks = cus * per_cu;
  }
  Params p{};
  const float** pp = (const float**)&p;
  for (int i = 0; i < 30; ++i) pp[i] = (const float*)d_in[i];
  p.out = (float*)d_out;
  p.ws = (unsigned char*)d_ws;
  if (ws_size < WS_END) { fprintf(stderr, "workspace too small: %zu < %zu\n", ws_size, (size_t)WS_END); return; }
  hipMemsetAsync(p.ws + OFF_BAR, 0, XCD_BAR_WORDS * 4, stream);
#if MULTI_LAUNCH
  for (int ph = 0; ph < NPH; ++ph) {
    hipLaunchKernelGGL(fwd_megakernel, dim3(grid_blocks), dim3(256), 0, stream, p, ph, ph + 1);
  }
#else
  int ph0 = 0, ph1 = NPH;
  void* args[] = {&p, &ph0, &ph1};
  hipError_t e = hipLaunchCooperativeKernel((void*)fwd_megakernel, dim3(grid_blocks), dim3(256), args, 0, stream);
  if (e != hipSuccess) fprintf(stderr, "cooperative launch failed: %s (grid %d)\n", hipGetErrorString(e), grid_blocks);
#endif
}
```

```cpp
#include <hip/hip_runtime.h>
#include <hip/hip_cooperative_groups.h>
#include <cstdio>
#include <cstdint>
namespace cg = cooperative_groups;

#ifndef MULTI_LAUNCH
#define MULTI_LAUNCH 0
#endif

#define DEVI __device__ __forceinline__
#define LDS_AS __attribute__((address_space(3)))
typedef unsigned short bf16_t;
typedef _Float16 f16_t;
typedef short bf16x8 __attribute__((ext_vector_type(8)));
typedef float f32x16 __attribute__((ext_vector_type(16)));
typedef float f32x4 __attribute__((ext_vector_type(4)));
typedef unsigned u32x4 __attribute__((ext_vector_type(4)));
typedef unsigned u32x2 __attribute__((ext_vector_type(2)));
typedef _Float16 f16x4 __attribute__((ext_vector_type(4)));
typedef _Float16 f16x8 __attribute__((ext_vector_type(8)));

constexpr int DM = 1024, NB = 4, SEQ = 8192, DEPTH = 4, CTX = 256;
constexpr int TL = NB * SEQ, TC = NB * CTX, NT = TL + TC;
constexpr int RC = 1792, INC = 3328, DFF = 4096, NKEY = SEQ + CTX;
constexpr int NPH = 2 + DEPTH * 10;

constexpr size_t SZ_T512x2 = (size_t)NT * 512 * 2;
constexpr size_t OFF_QK = 0;
constexpr size_t OFF_VT = OFF_QK + 2 * SZ_T512x2;
constexpr size_t OFF_ZR = OFF_VT + SZ_T512x2;
constexpr size_t OFF_Y = OFF_ZR + 3 * SZ_T512x2;
constexpr size_t OFF_LA = OFF_Y;
constexpr size_t OFF_HID = 0;
constexpr size_t OFF_B = 8 * SZ_T512x2;
constexpr size_t OFF_GATE = OFF_B;
constexpr size_t OFF_EW = OFF_B + SZ_T512x2;
constexpr size_t OFF_AA = OFF_B + 3 * SZ_T512x2;
constexpr size_t OFF_F = OFF_B;
constexpr size_t OFF_ZA = OFF_B;
constexpr size_t SZ_W = (size_t)(1024 * 1024 + 2 * 1024 * 4096) * 2;
constexpr size_t OFF_W = OFF_B + 5 * SZ_T512x2 - SZ_W;
constexpr size_t OFF_H = OFF_B + 5 * SZ_T512x2;
constexpr size_t OFF_XC = OFF_H + 2 * SZ_T512x2;
constexpr size_t OFF_KN = OFF_XC + (size_t)TC * 1024 * 4;
constexpr size_t OFF_MOD = OFF_KN + (size_t)NT * 8 * 4;
constexpr size_t OFF_LW = OFF_MOD + (size_t)DEPTH * 5 * 6144 * 4;
constexpr size_t OFF_ROPE = OFF_LW + (size_t)DEPTH * 196608 * 2;
constexpr size_t OFF_CTR = OFF_ROPE + 128 * 8 * 8;
constexpr size_t OFF_KM = OFF_CTR + 256;
constexpr size_t OFF_BAR = OFF_KM + 256;
constexpr size_t WS_END = OFF_BAR + 3456 * 4;
static_assert((size_t)NT * 1024 * 4 <= 5 * SZ_T512x2 - SZ_W, "F overlaps W");
static_assert((size_t)NT * RC * 2 <= 5 * SZ_T512x2 - SZ_W, "ZA overlaps W");
static_assert(WS_END <= (size_t)536870912, "workspace too big");

struct Params {
  const float *x, *c, *ctx, *c_ctx, *ada_w, *ada_b, *g_pre_mix, *g_post_mix, *g_pre_mlp, *g_post_mlp,
      *w_in, *shift_mu, *k_k, *k_a, *w0, *w_b, *a0, *a_b, *g_b, *r_k, *lnx_g, *lnx_b,
      *lam_q1, *lam_k1, *lam_q2, *lam_k2, *subln_g, *w_out, *w_ff1, *w_ff2;
  float* out;
  unsigned char* ws;
};

DEVI unsigned pk_bf16(float lo, float hi) {
  unsigned r;
  asm("v_cvt_pk_bf16_f32 %0, %1, %2" : "=v"(r) : "v"(lo), "v"(hi));
  return r;
}
DEVI bf16_t f2bf(float f) { return (bf16_t)(pk_bf16(f, 0.f) & 0xffffu); }
DEVI float bflo(unsigned u) { return __uint_as_float(u << 16); }
DEVI float bfhi(unsigned u) { return __uint_as_float(u & 0xffff0000u); }
DEVI int get_tid() { int t = threadIdx.x; asm volatile("" : "+v"(t)); return t; }
DEVI float sigmoidf_(float x) { return __builtin_amdgcn_rcpf(1.0f + __expf(-x)); }
DEVI int lane_id_() { int l = (int)__builtin_amdgcn_mbcnt_hi(~0u, __builtin_amdgcn_mbcnt_lo(~0u, 0u)); asm volatile("" : "+v"(l)); return l; }
DEVI float shfl_xor_(float v, int o) { return __int_as_float(__builtin_amdgcn_ds_bpermute((lane_id_() ^ o) << 2, __float_as_int(v))); }
DEVI float wave_sum(float v) {
#pragma unroll
  for (int o = 32; o >= 1; o >>= 1) v += shfl_xor_(v, o);
  return v;
}
template <int CTRL> DEVI float dpp_add(float v) {
  int t = __builtin_amdgcn_update_dpp(0, __float_as_int(v), CTRL, 0xf, 0xf, true);
  return v + __int_as_float(t);
}
template <int CTRL> DEVI float dpp_get(float v) {
  return __int_as_float(__builtin_amdgcn_update_dpp(0, __float_as_int(v), CTRL, 0xf, 0xf, true));
}
DEVI float allreduce16(float v) {
  v = dpp_add<0xB1>(v);
  v = dpp_add<0x4E>(v);
  v = dpp_add<0x141>(v);
  v = dpp_add<0x140>(v);
  return v;
}
DEVI float* xrow(const Params& p, int row) {
  return row < TL ? p.out + (size_t)row * 1024 : (float*)(p.ws + OFF_XC) + (size_t)(row - TL) * 1024;
}
DEVI const float* xin_row(const Params& p, int row) {
  return row < TL ? p.x + (size_t)row * 1024 : p.ctx + (size_t)(row - TL) * 1024;
}
DEVI int mod_idx(int row) { return row < TL ? (row >> 13) : 4; }

DEVI void convert_tile(const float* __restrict__ src, int K, int N, bf16_t* __restrict__ dst, int tk, int tn,
                       unsigned char* smem) {
  float* tile = (float*)smem;
  const int tid = get_tid();
  {
    const int kr = tid >> 4, nc = (tid & 15) * 4;
#pragma unroll
    for (int i = 0; i < 4; ++i) {
      const int k = kr + i * 16;
      const f32x4 v = __builtin_nontemporal_load((const f32x4*)(src + (size_t)(tk * 64 + k) * N + tn * 64 + nc));
      tile[k * 65 + nc + 0] = v[0]; tile[k * 65 + nc + 1] = v[1];
      tile[k * 65 + nc + 2] = v[2]; tile[k * 65 + nc + 3] = v[3];
    }
  }
  __syncthreads();
  {
    const int n = tid >> 2, kc = (tid & 3) * 16;
    u32x4 o0, o1;
    o0[0] = pk_bf16(tile[(kc + 0) * 65 + n], tile[(kc + 1) * 65 + n]);
    o0[1] = pk_bf16(tile[(kc + 2) * 65 + n], tile[(kc + 3) * 65 + n]);
    o0[2] = pk_bf16(tile[(kc + 4) * 65 + n], tile[(kc + 5) * 65 + n]);
    o0[3] = pk_bf16(tile[(kc + 6) * 65 + n], tile[(kc + 7) * 65 + n]);
    o1[0] = pk_bf16(tile[(kc + 8) * 65 + n], tile[(kc + 9) * 65 + n]);
    o1[1] = pk_bf16(tile[(kc + 10) * 65 + n], tile[(kc + 11) * 65 + n]);
    o1[2] = pk_bf16(tile[(kc + 12) * 65 + n], tile[(kc + 13) * 65 + n]);
    o1[3] = pk_bf16(tile[(kc + 14) * 65 + n], tile[(kc + 15) * 65 + n]);
    bf16_t* d = dst + (size_t)(tn * 64 + n) * K + tk * 64 + kc;
    *(u32x4*)d = o0;
    *(u32x4*)(d + 8) = o1;
  }
  __syncthreads();
}
DEVI void convert_matrix(const float* src, int K, int N, bf16_t* dst, unsigned char* smem) {
  const int nk = K / 64, nn = N / 64;
  for (int t = blockIdx.x; t < nk * nn; t += gridDim.x) convert_tile(src, K, N, dst, t / nn, t % nn, smem);
}

enum { EPI_F32 = 0, EPI_BF16 = 1, EPI_RELU2 = 2, EPI_EW = 3, EPI_SIG = 4, EPI_F16 = 5, EPI_G1 = 6 };
struct GemmJob {
  const bf16_t* A; int lda;
  const bf16_t* Bt;
  int K, M, N, epi;
  void* out; int ldc;
  const float* bias;
};

template <int EPI> DEVI void gemm_tile(const Params& p, const GemmJob& g, int tm, int tn, unsigned char* smem) {
  const int tid = get_tid(), lane = tid & 63, wave = tid >> 6;
  const int wm = wave >> 1, wn = wave & 1, r32 = lane & 31, hh = lane >> 5;
  const int lrow = tid >> 3, lch = tid & 7;
  const bf16_t* Ag[4];
  const bf16_t* Bg[4];
#pragma unroll
  for (int i = 0; i < 4; ++i) {
    const int row = lrow + i * 32, c = lch ^ ((row >> 1) & 7);
    Ag[i] = g.A + (size_t)(tm * 128 + row) * g.lda + c * 8;
    Bg[i] = g.Bt + (size_t)(tn * 128 + row) * g.K + c * 8;
  }
  f32x16 acc[2][2];
#pragma unroll
  for (int i = 0; i < 2; ++i)
#pragma unroll
    for (int j = 0; j < 2; ++j)
#pragma unroll
      for (int e = 0; e < 16; ++e) acc[i][j][e] = 0.f;
  const int nk = g.K >> 6;
  unsigned char* lds_t = smem + tid * 16;
#define GEMM_STAGE(kt_, buf_)                                                                                   \
  {                                                                                                             \
    _Pragma("unroll") for (int i = 0; i < 4; ++i) {                                                             \
      __builtin_amdgcn_global_load_lds((const unsigned*)(Ag[i] + (kt_) * 64), (LDS_AS unsigned*)(lds_t + (buf_) * 32768 + i * 4096), 16, 0, 0);          \
      __builtin_amdgcn_global_load_lds((const unsigned*)(Bg[i] + (kt_) * 64), (LDS_AS unsigned*)(lds_t + (buf_) * 32768 + 16384 + i * 4096), 16, 0, 0);  \
    }                                                                                                           \
  }
  GEMM_STAGE(0, 0);
  asm volatile("s_waitcnt vmcnt(0)" ::: "memory");
  __syncthreads();
  int aoff[2], boff[2];
#pragma unroll
  for (int mi = 0; mi < 2; ++mi) { const int row = wm * 64 + mi * 32 + r32; aoff[mi] = row * 128; }
#pragma unroll
  for (int ni = 0; ni < 2; ++ni) { const int row = wn * 64 + ni * 32 + r32; boff[ni] = 16384 + row * 128; }
  const int sw = (r32 >> 1) & 7;
  for (int kt = 0; kt < nk; ++kt) {
    const bool more = (kt + 1 < nk);
    const unsigned char* base = smem + (kt & 1) * 32768;
    bf16x8 a[4][2], b[4][2];
#pragma unroll
    for (int ks = 0; ks < 4; ++ks) {
      const int co = ((ks * 2 + hh) ^ sw) << 4;
#pragma unroll
      for (int mi = 0; mi < 2; ++mi) a[ks][mi] = *(const bf16x8*)(base + aoff[mi] + co);
#pragma unroll
      for (int ni = 0; ni < 2; ++ni) b[ks][ni] = *(const bf16x8*)(base + boff[ni] + co);
    }
    __builtin_amdgcn_sched_barrier(0);
    if (more) GEMM_STAGE(kt + 1, (kt + 1) & 1);
    __builtin_amdgcn_sched_barrier(0);
#pragma unroll
    for (int ks = 0; ks < 4; ++ks)
#pragma unroll
      for (int mi = 0; mi < 2; ++mi)
#pragma unroll
        for (int ni = 0; ni < 2; ++ni)
          acc[mi][ni] = __builtin_amdgcn_mfma_f32_32x32x16_bf16(a[ks][mi], b[ks][ni], acc[mi][ni], 0, 0, 0);
    __builtin_amdgcn_sched_barrier(0);
    asm volatile("s_waitcnt vmcnt(0)" ::: "memory");
    __syncthreads();
  }
#undef GEMM_STAGE
  const int row_b = tm * 128 + wm * 64 + 4 * hh, col_b = tn * 128 + wn * 64 + r32;
  constexpr int epi = EPI;
  if (epi == EPI_G1 && tn >= 22) {
    bf16_t* VT = (bf16_t*)(p.ws + OFF_VT);
#pragma unroll
    for (int mi = 0; mi < 2; ++mi)
#pragma unroll
      for (int ni = 0; ni < 2; ++ni) {
        const int n2 = col_b + ni * 32 - 2816;
        const int head = n2 >> 6, dv = n2 & 63;
#pragma unroll
        for (int jq = 0; jq < 4; ++jq) {
          const int row = row_b + mi * 32 + 8 * jq;
          int b, key;
          if (row < TL) { b = row >> 13; key = row & 8191; } else { b = (row - TL) >> 8; key = 8192 + ((row - TL) & 255); }
          u32x2 w;
          w[0] = pk_bf16(acc[mi][ni][4 * jq + 0], acc[mi][ni][4 * jq + 1]);
          w[1] = pk_bf16(acc[mi][ni][4 * jq + 2], acc[mi][ni][4 * jq + 3]);
          *(u32x2*)(VT + (size_t)((b * 8 + head) * 64 + dv) * NKEY + key) = w;
        }
      }
    return;
  }
  float* ct = (float*)smem;
#pragma unroll
  for (int mi = 0; mi < 2; ++mi)
#pragma unroll
    for (int ni = 0; ni < 2; ++ni) {
      const int col_l = wn * 64 + ni * 32 + r32;
      float bias = 0.f;
      if (epi == EPI_EW || epi == EPI_SIG) bias = g.bias[tn * 128 + col_l];
#pragma unroll
      for (int j = 0; j < 16; ++j) {
        const int row_l = wm * 64 + mi * 32 + (j & 3) + 8 * (j >> 2) + 4 * hh;
        float v = acc[mi][ni][j];
        if (epi == EPI_RELU2) { v = fmaxf(v, 0.f); v = v * v; }
        else if (epi == EPI_EW) v = -0.6065306597f * sigmoidf_(v + bias);
        else if (epi == EPI_SIG) v = sigmoidf_(v + bias);
        ct[row_l * 128 + col_l] = v;
      }
    }
  __syncthreads();
  {
    unsigned short* outp; int ldc, col0;
    if (epi == EPI_G1) {
      if (tn < 14) { outp = (unsigned short*)(p.ws + OFF_ZA); ldc = RC; col0 = tn * 128; }
      else { outp = (unsigned short*)(p.ws + OFF_QK); ldc = 1024; col0 = tn * 128 - RC; }
    } else { outp = (unsigned short*)g.out; ldc = g.ldc; col0 = tn * 128; }
    constexpr bool F16OUT = (epi == EPI_EW || epi == EPI_SIG || epi == EPI_F16);
#pragma unroll
    for (int i = 0; i < 8; ++i) {
      const int q = tid + 256 * i, row_l = q >> 4, cc = (q & 15) * 8;
      const f32x4 v0 = *(const f32x4*)(ct + row_l * 128 + cc), v1 = *(const f32x4*)(ct + row_l * 128 + cc + 4);
      u32x4 w;
      if (F16OUT) {
        f16x8 h;
        h[0] = (f16_t)v0[0]; h[1] = (f16_t)v0[1]; h[2] = (f16_t)v0[2]; h[3] = (f16_t)v0[3];
        h[4] = (f16_t)v1[0]; h[5] = (f16_t)v1[1]; h[6] = (f16_t)v1[2]; h[7] = (f16_t)v1[3];
        w = __builtin_bit_cast(u32x4, h);
      } else {
        w[0] = pk_bf16(v0[0], v0[1]); w[1] = pk_bf16(v0[2], v0[3]); w[2] = pk_bf16(v1[0], v1[1]); w[3] = pk_bf16(v1[2], v1[3]);
      }
      __builtin_nontemporal_store(w, (u32x4*)(outp + (size_t)(tm * 128 + row_l) * ldc + col0 + cc));
    }
  }
  __syncthreads();
}
struct Place { int xcc, rank, swz, scanpref; };
template <int EPI> DEVI void gemm_run(const Params& p, const GemmJob& g, unsigned char* smem, const Place& pl) {
  const int nm = g.M >> 7, nn = g.N >> 7;
  if (pl.swz) {
    const int nsn = nn >> 3, nn8 = nsn << 3, nsm = (nm + 7) >> 3;
    const int lm = pl.rank >> 3, ln = pl.rank & 7;
    for (int sid = pl.xcc; sid < nsm * nsn; sid += 8) {
      const int sm = sid / nsn, sn = sid - sm * nsn;
      const int tm = sm * 8 + lm, tn = sn * 8 + ln;
      if (tm < nm) gemm_tile<EPI>(p, g, tm, tn, smem);
    }
    const int rem = nn - nn8;
    for (int t = blockIdx.x; t < nm * rem; t += gridDim.x) gemm_tile<EPI>(p, g, t / rem, nn8 + t % rem, smem);
  } else {
    for (int t = blockIdx.x; t < nm * nn; t += gridDim.x) gemm_tile<EPI>(p, g, t / nn, t % nn, smem);
  }
}

DEVI void modvec_item(const Params& p, int item, unsigned char* smem) {
  const int l = item / 96, chunk = item % 96, tid = get_tid();
  float* sc = (float*)smem;
  float* red = (float*)(smem + 20480);
  for (int i = tid; i < 5 * 1024; i += 256) {
    const int b = i >> 10, k = i & 1023;
    const float v = b < 4 ? p.c[b * 1024 + k] : p.c_ctx[k];
    sc[i] = v * sigmoidf_(v);
  }
  __syncthreads();
  const int col = tid & 63, kg = tid >> 6;
  const float* w = p.ada_w + (size_t)l * 1024 * 6144 + chunk * 64 + col;
  float a0 = 0, a1 = 0, a2 = 0, a3 = 0, a4 = 0;
#pragma unroll 8
  for (int k = kg * 256; k < kg * 256 + 256; ++k) {
    const float wv = __builtin_nontemporal_load(w + (size_t)k * 6144);
    a0 += sc[k] * wv; a1 += sc[1024 + k] * wv; a2 += sc[2048 + k] * wv; a3 += sc[3072 + k] * wv; a4 += sc[4096 + k] * wv;
  }
  red[(kg * 5 + 0) * 64 + col] = a0; red[(kg * 5 + 1) * 64 + col] = a1; red[(kg * 5 + 2) * 64 + col] = a2;
  red[(kg * 5 + 3) * 64 + col] = a3; red[(kg * 5 + 4) * 64 + col] = a4;
  __syncthreads();
  float* MOD = (float*)(p.ws + OFF_MOD);
  for (int i = tid; i < 5 * 64; i += 256) {
    const int b = i >> 6, cc = i & 63;
    const float s = red[(0 * 5 + b) * 64 + cc] + red[(1 * 5 + b) * 64 + cc] + red[(2 * 5 + b) * 64 + cc] + red[(3 * 5 + b) * 64 + cc];
    const int gc = chunk * 64 + cc;
    MOD[(size_t)(l * 5 + b) * 6144 + gc] = s + p.ada_b[l * 6144 + gc];
  }
  __syncthreads();
}

DEVI void phase_setup(const Params& p, unsigned char* smem) {
  const int tid = get_tid();
  if (blockIdx.x == 0) {
    if (tid < 64) ((int*)(p.ws + OFF_CTR))[tid] = 0;
  }
  if (blockIdx.x == (gridDim.x > 1 ? 1 : 0)) {
    float2* RT = (float2*)(p.ws + OFF_ROPE);
    for (int i = tid; i < 1024; i += 256) {
      const int pos = i >> 3, f = i & 7;
      const float invf[8] = {1.0f, 0.31622776601683794f, 0.1f, 0.03162277660168379f, 0.01f, 0.003162277660168379f, 0.001f, 0.00031622776601683794f};
      float fr = 1.0f;
#pragma unroll
      for (int q = 0; q < 8; ++q) if (f == q) fr = invf[q];
      const float ang = (float)pos * fr;
      const double rev = (double)ang * 0.15915494309189535;
      const float fx = (float)(rev - floor(rev));
      RT[i] = make_float2(__builtin_amdgcn_cosf(fx), __builtin_amdgcn_sinf(fx));
    }
  }
  for (int it = blockIdx.x; it < DEPTH * 96; it += gridDim.x) modvec_item(p, it, smem);
  for (int it = blockIdx.x; it < DEPTH * 48; it += gridDim.x) {
    const int l = it / 48, r = it % 48;
    bf16_t* LW = (bf16_t*)(p.ws + OFF_LW) + (size_t)l * 196608;
    if (r < 32) {
      const int m = r >> 3, t = r & 7;
      const float* src = (m < 2 ? p.w_b : p.a_b) + (size_t)(l * 2 + (m & 1)) * 64 * 512;
      convert_tile(src, 64, 512, LW + m * 32768, 0, t, smem);
    } else {
      const int t = r - 32;
      convert_tile(p.g_b + (size_t)l * 128 * 512, 128, 512, LW + 131072, t >> 3, t & 7, smem);
    }
  }
  convert_matrix(p.w_in, 1024, INC, (bf16_t*)(p.ws + OFF_W), smem);
}

DEVI void rowpass(const Params& p, int mode, int l) {
  const int tid = get_tid(), lane = tid & 63, wave = tid >> 6;
  const int nrows = (l == DEPTH - 1 && mode >= 1) ? TL : NT;
  const float* MOD = (const float*)(p.ws + OFF_MOD);
  const bool from_in = (mode == 0 || (mode == 1 && l == 0));
  const int stride = gridDim.x * 4;
  f32x4 xv[4], fv[4], nxv[4], nfv[4];
#define RP_LOAD(XV, FV, r_)                                                                        \
  { const float* xs_ = from_in ? xin_row(p, (r_)) : xrow(p, (r_));                                 \
    _Pragma("unroll") for (int j = 0; j < 4; ++j) XV[j] = __builtin_nontemporal_load((const f32x4*)(xs_ + j * 256 + lane * 4)); \
    if (mode != 0) { const bf16_t* F_ = (const bf16_t*)(p.ws + OFF_F) + (size_t)(r_) * 1024;        \
      _Pragma("unroll") for (int j = 0; j < 4; ++j) { const u32x2 w_ = __builtin_nontemporal_load((const u32x2*)(F_ + j * 256 + lane * 4)); \
        FV[j][0] = bflo(w_[0]); FV[j][1] = bfhi(w_[0]); FV[j][2] = bflo(w_[1]); FV[j][3] = bfhi(w_[1]); } } }
#pragma unroll
  for (int j = 0; j < 4; ++j) { fv[j] = (f32x4){0.f, 0.f, 0.f, 0.f}; nfv[j] = fv[j]; nxv[j] = fv[j]; xv[j] = fv[j]; }
  int row = blockIdx.x * 4 + wave;
  if (row < nrows) RP_LOAD(xv, fv, row);
  for (; row < nrows; row += stride) {
    const int mi = mod_idx(row);
    if (row + stride < nrows) RP_LOAD(nxv, nfv, row + stride);
    if (mode != 0) {
      float ss = 0.f;
#pragma unroll
      for (int j = 0; j < 4; ++j) ss += fv[j][0] * fv[j][0] + fv[j][1] * fv[j][1] + fv[j][2] * fv[j][2] + fv[j][3] * fv[j][3];
      ss = wave_sum(ss);
      const float rstd = rsqrtf(ss * (1.0f / 1024.0f) + 1e-6f);
      const float* gpost = (mode == 1 ? p.g_post_mix : p.g_post_mlp) + l * 1024;
      const float* gate = MOD + (size_t)((l * 5 + mi) * 6 + (mode == 1 ? 2 : 5)) * 1024;
      float* xd = xrow(p, row);
#pragma unroll
      for (int j = 0; j < 4; ++j) {
        const f32x4 gp = *(const f32x4*)(gpost + j * 256 + lane * 4);
        const f32x4 gt = *(const f32x4*)(gate + j * 256 + lane * 4);
        xv[j] = xv[j] + gt * (fv[j] * rstd * gp);
        __builtin_nontemporal_store(xv[j], (f32x4*)(xd + j * 256 + lane * 4));
      }
    }
    if (!(mode == 2 && l == DEPTH - 1)) {
      const int l2 = (mode == 2) ? l + 1 : l;
      const float* gpre = (mode == 1 ? p.g_pre_mlp : p.g_pre_mix) + l2 * 1024;
      const float* sh = MOD + (size_t)((l2 * 5 + mi) * 6 + (mode == 1 ? 3 : 0)) * 1024;
      const float* sc = sh + 1024;
      float ss = 0.f;
#pragma unroll
      for (int j = 0; j < 4; ++j) ss += xv[j][0] * xv[j][0] + xv[j][1] * xv[j][1] + xv[j][2] * xv[j][2] + xv[j][3] * xv[j][3];
      ss = wave_sum(ss);
      const float rstd = rsqrtf(ss * (1.0f / 1024.0f) + 1e-6f);
      bf16_t* H = (bf16_t*)(p.ws + OFF_H) + (size_t)row * 1024;
#pragma unroll
      for (int j = 0; j < 4; ++j) {
        const f32x4 gp = *(const f32x4*)(gpre + j * 256 + lane * 4);
        const f32x4 s1 = *(const f32x4*)(sc + j * 256 + lane * 4);
        const f32x4 s0 = *(const f32x4*)(sh + j * 256 + lane * 4);
        const f32x4 hv = (xv[j] * rstd * gp) * (1.0f + s1) + s0;
        u32x2 w;
        w[0] = pk_bf16(hv[0], hv[1]); w[1] = pk_bf16(hv[2], hv[3]);
        *(u32x2*)(H + j * 256 + lane * 4) = w;
      }
    }
#pragma unroll
    for (int j = 0; j < 4; ++j) { xv[j] = nxv[j]; fv[j] = nfv[j]; }
  }
#undef RP_LOAD
}

DEVI void p1_shift(const Params& p, int l) {
  const bf16_t* ZA = (const bf16_t*)(p.ws + OFF_ZA);
  bf16_t* ZR = (bf16_t*)(p.ws + OFF_ZR);
  bf16_t* LA = (bf16_t*)(p.ws + OFF_LA);
  float* KN = (float*)(p.ws + OFF_KN);
  const float* mu = p.shift_mu + l * RC;
  const float* kkw = p.k_k + l * 512;
  const int total = NT * 224;
  for (int idx = blockIdx.x * 256 + get_tid(); idx < total; idx += gridDim.x * 256) {
    const int row = idx / 224, ch = idx - row * 224, col = ch * 8;
    int pos, len;
    if (row < TL) { pos = row & 8191; len = 8192; } else { pos = (row - TL) & 255; len = 256; }
    const bf16_t* zp = ZA + (size_t)row * RC + col;
    const u32x4 zc = *(const u32x4*)zp;
    u32x4 zl = {0, 0, 0, 0}, zn = {0, 0, 0, 0};
    if (pos > 0) zl = *(const u32x4*)(zp - RC);
    if (pos < len - 1) zn = *(const u32x4*)(zp + RC);
    const f32x4 m0 = *(const f32x4*)(mu + col), m1 = *(const f32x4*)(mu + col + 4);
    float zs[8];
#pragma unroll
    for (int j = 0; j < 4; ++j) {
      const float c0 = bflo(zc[j]), c1 = bfhi(zc[j]);
      const float n0 = 0.5f * (bflo(zl[j]) + bflo(zn[j])), n1 = 0.5f * (bfhi(zl[j]) + bfhi(zn[j]));
      const float mu0 = (2 * j < 4) ? m0[2 * j] : m1[2 * j - 4];
      const float mu1 = (2 * j + 1 < 4) ? m0[2 * j + 1] : m1[2 * j + 1 - 4];
      zs[2 * j] = c0 + mu0 * (n0 - c0);
      zs[2 * j + 1] = c1 + mu1 * (n1 - c1);
    }
    float ksq = 0.f;
    const bool isk = (col >= 512 && col < 1024);
    if (col < 1536) {
      u32x4 o;
#pragma unroll
      for (int j = 0; j < 4; ++j) o[j] = pk_bf16(zs[2 * j], zs[2 * j + 1]);
      __builtin_nontemporal_store(o, (u32x4*)(ZR + (size_t)row * 1536 + col));
      if (isk) {
        const f32x4 k0 = *(const f32x4*)(kkw + col - 512), k1 = *(const f32x4*)(kkw + col - 512 + 4);
#pragma unroll
        for (int j = 0; j < 4; ++j) { const float a = zs[j] * k0[j], b = zs[4 + j] * k1[j]; ksq += a * a + b * b; }
      }
    } else {
      const int lc = col - 1536;
      float v[8];
#pragma unroll
      for (int j = 0; j < 8; ++j) {
        if (lc < 64) { const float e = __expf(2.0f * zs[j]); v[j] = 1.0f - 2.0f / (e + 1.0f); }
        else if (lc < 128) v[j] = zs[j];
        else v[j] = sigmoidf_(zs[j]);
      }
      u32x4 o;
#pragma unroll
      for (int j = 0; j < 4; ++j) o[j] = pk_bf16(v[2 * j], v[2 * j + 1]);
      __builtin_nontemporal_store(o, (u32x4*)(LA + (size_t)row * 256 + lc));
    }
    ksq += shfl_xor_(ksq, 1); ksq += shfl_xor_(ksq, 2); ksq += shfl_xor_(ksq, 4);
    if (isk && (ch & 7) == 0) KN[row * 8 + ((col - 512) >> 6)] = 1.0f / fmaxf(sqrtf(ksq), 1e-12f);
  }
}

DEVI void p1_rope(const Params& p) {
  bf16_t* QK = (bf16_t*)(p.ws + OFF_QK);
  const float2* RT = (const float2*)(p.ws + OFF_ROPE);
  const float qs = 0.17677669529663687f * 1.4426950408889634f;
  const int total = NT * 64;
  for (int idx = blockIdx.x * 256 + get_tid(); idx < total; idx += gridDim.x * 256) {
    const int row = idx >> 6, u = idx & 63, col = u * 16;
    const bool isq = col < 512;
    if (row >= TL && !isq) continue;
    bf16_t* ptr = QK + (size_t)row * 1024 + col;
    const u32x4 a = *(const u32x4*)ptr, b = *(const u32x4*)(ptr + 8);
    float x1[8], x2[8];
#pragma unroll
    for (int j = 0; j < 4; ++j) { x1[2 * j] = bflo(a[j]); x1[2 * j + 1] = bfhi(a[j]); x2[2 * j] = bflo(b[j]); x2[2 * j + 1] = bfhi(b[j]); }
    if (row < TL) {
      const int t = row & 8191;
      const int pos = (u & 1) ? (t & 63) : (t >> 6);
#pragma unroll
      for (int i = 0; i < 8; ++i) {
        const float2 cs = RT[pos * 8 + i];
        const float o1 = x1[i] * cs.x - x2[i] * cs.y, o2 = x1[i] * cs.y + x2[i] * cs.x;
        x1[i] = o1; x2[i] = o2;
      }
    }
    if (isq) {
#pragma unroll
      for (int i = 0; i < 8; ++i) { x1[i] *= qs; x2[i] *= qs; }
    }
    u32x4 oa, ob;
#pragma unroll
    for (int j = 0; j < 4; ++j) { oa[j] = pk_bf16(x1[2 * j], x1[2 * j + 1]); ob[j] = pk_bf16(x2[2 * j], x2[2 * j + 1]); }
    *(u32x4*)ptr = oa;
    *(u32x4*)(ptr + 8) = ob;
  }
}

typedef float f32x2 __attribute__((ext_vector_type(2)));
struct ScOp { f32x4 w, kk, nb, km, r; float v; };
DEVI void sc_ld(ScOp& o, const float* tb, const float* vp) {
  o.w = *(const f32x4*)tb; o.kk = *(const f32x4*)(tb + 64); o.nb = *(const f32x4*)(tb + 128);
  o.km = *(const f32x4*)(tb + 192); o.r = *(const f32x4*)(tb + 256); o.v = *vp;
}
constexpr int SC_TOK = 16, SC_STRIDE = 336;
struct ScRaw { u32x2 gr, gk, gv; f16x4 gew, ga; float gkn; };
DEVI void scan_item(const Params& p, int l, int item, unsigned char* smem) {
  const int tid = get_tid(), lane = tid & 63, wave = tid >> 6;
  const int rg = item & 3, dir = (item >> 2) & 1, h = (item >> 3) & 7, b = item >> 6;
  const int rl = lane >> 4, kl = lane & 15;
  float* IN = (float*)smem;
  float* YB = (float*)(smem + 2 * SC_TOK * SC_STRIDE * 4);
  const bf16_t* ZR = (const bf16_t*)(p.ws + OFF_ZR);
  const f16_t* EW = (const f16_t*)(p.ws + OFF_EW) + (size_t)dir * NT * 512;
  const f16_t* AA = (const f16_t*)(p.ws + OFF_AA) + (size_t)dir * NT * 512;
  const float* KN = (const float*)(p.ws + OFF_KN);
  f16_t* Y = (f16_t*)(p.ws + OFF_Y) + (size_t)dir * NT * 512;
  const int tl = tid >> 4, cg4 = (tid & 15) * 4;
  const f32x4 kkc = *(const f32x4*)(p.k_k + l * 512 + h * 64 + cg4);
  const f32x4 kac = *(const f32x4*)(p.k_a + l * 512 + h * 64 + cg4);
  ScRaw RA, RB;
  RA.gv[0] = 0; RA.gv[1] = 0; RB.gv[0] = 0; RB.gv[1] = 0;
#define SC_ROW(s, rowvar)                                                        \
  {                                                                              \
    int s_ = (s);                                                                \
    if (s_ < 256) rowvar = TL + b * 256 + (dir ? 255 - s_ : s_);                 \
    else { s_ -= 256; rowvar = b * 8192 + (dir ? 8191 - s_ : s_); }              \
  }
#define SC_LOAD(c, R)                                                            \
  {                                                                              \
    int row; SC_ROW((c) * SC_TOK + tl, row);                                     \
    const bf16_t* zr = ZR + (size_t)row * 1536 + h * 64 + cg4;                   \
    R.gr = *(const u32x2*)zr; R.gk = *(const u32x2*)(zr + 512);                  \
    if (cg4 < 16) R.gv = *(const u32x2*)(ZR + (size_t)row * 1536 + 1024 + h * 64 + rg * 16 + cg4); \
    R.gew = *(const f16x4*)(EW + (size_t)row * 512 + h * 64 + cg4);              \
    R.ga = *(const f16x4*)(AA + (size_t)row * 512 + h * 64 + cg4);               \
    R.gkn = KN[row * 8 + h];                                                     \
  }
#define SC_STAGE(buf, R)                                                         \
  {                                                                              \
    float* dst = IN + ((buf) * SC_TOK + tl) * SC_STRIDE + cg4;                   \
    const float kf[4] = {bflo(R.gk[0]), bfhi(R.gk[0]), bflo(R.gk[1]), bfhi(R.gk[1])}; \
    f32x4 w4, kk4, b4, km4, r4;                                                  \
    r4[0] = bflo(R.gr[0]); r4[1] = bfhi(R.gr[0]); r4[2] = bflo(R.gr[1]); r4[3] = bfhi(R.gr[1]); \
    _Pragma("unroll") for (int j = 0; j < 4; ++j) {                              \
      const float a = (float)R.ga[j];                                            \
      w4[j] = __expf((float)R.gew[j]);                                           \
      kk4[j] = kf[j] * kkc[j] * R.gkn;                                           \
      b4[j] = -kk4[j] * a;                                                       \
      km4[j] = kf[j] * (1.0f + (a - 1.0f) * kac[j]);                             \
    }                                                                            \
    *(f32x4*)(dst) = w4; *(f32x4*)(dst + 64) = kk4; *(f32x4*)(dst + 128) = b4;   \
    *(f32x4*)(dst + 192) = km4; *(f32x4*)(dst + 256) = r4;                       \
    if (cg4 < 16) {                                                              \
      f32x4 v4; v4[0] = bflo(R.gv[0]); v4[1] = bfhi(R.gv[0]); v4[2] = bflo(R.gv[1]); v4[3] = bfhi(R.gv[1]); \
      *(f32x4*)(IN + ((buf) * SC_TOK + tl) * SC_STRIDE + 320 + cg4) = v4;        \
    }                                                                            \
  }
#define SC_STEP(J)                                                                                            \
    {                                                                                                         \
      if ((J) + 2 < SC_TOK) sc_ld(ops[((J) + 2) % 3], in + ((J) + 2) * SC_STRIDE + kl * 4, in + ((J) + 2) * SC_STRIDE + vidx); \
      const ScOp& o = ops[(J) % 3];                                                                           \
      f32x2 pa = S01 * o.kk.xy;                                                                               \
      pa = S23 * o.kk.zw + pa;                                                                                \
      float sa = pa.x + pa.y;                                                                                 \
      const f32x2 vv = {o.v, o.v};                                                                            \
      f32x2 t01 = vv * o.km.xy, t23 = vv * o.km.zw;                                                           \
      t01 = S01 * o.w.xy + t01;                                                                               \
      t23 = S23 * o.w.zw + t23;                                                                               \
      sa = allreduce16(sa);                                                                                   \
      const f32x2 sv = {sa, sa};                                                                              \
      S01 = sv * o.nb.xy + t01;                                                                               \
      S23 = sv * o.nb.zw + t23;                                                                               \
      f32x2 py = S01 * o.r.xy;                                                                                \
      py = S23 * o.r.zw + py;                                                                                 \
      yp[J] = py.x + py.y;     \
    }
#define SC_CHUNK(BUF)                                                                                         \
    {                                                                                                         \
      const float* in = IN + (BUF) * SC_TOK * SC_STRIDE;                                                      \
      ScOp ops[3];                                                                                            \
      sc_ld(ops[0], in + kl * 4, in + vidx);                                                                  \
      sc_ld(ops[1], in + SC_STRIDE + kl * 4, in + SC_STRIDE + vidx);                                          \
      float yp[16];                                                                                           \
      SC_STEP(0) SC_STEP(1) SC_STEP(2) SC_STEP(3) SC_STEP(4) SC_STEP(5) SC_STEP(6) SC_STEP(7)                 \
      SC_STEP(8) SC_STEP(9) SC_STEP(10) SC_STEP(11) SC_STEP(12) SC_STEP(13) SC_STEP(14) SC_STEP(15)           \
        \
      float ya[8], yb4[4], yc[2];                                                                             \
      _Pragma("unroll") for (int i = 0; i < 8; ++i) {                                                         \
        const float keep = bit3 ? yp[i + 8] : yp[i], send = bit3 ? yp[i] : yp[i + 8];                         \
        ya[i] = keep + dpp_get<0x128>(send);                                         \
      }                                                                                                       \
      _Pragma("unroll") for (int i = 0; i < 4; ++i) {                                                         \
        const float keep = bit2 ? ya[i + 4] : ya[i], send = bit2 ? ya[i] : ya[i + 4];                         \
        yb4[i] = keep + dpp_get<0x141>(send);                                  \
      }                                                                                                       \
      _Pragma("unroll") for (int i = 0; i < 2; ++i) {                                                         \
        const float keep = bit1 ? yb4[i + 2] : yb4[i], send = bit1 ? yb4[i] : yb4[i + 2];                     \
        yc[i] = keep + dpp_get<0x4E>(send);                                \
      }                                                                                                       \
      const float ykeep = bit0 ? yc[1] : yc[0], ysend = bit0 ? yc[0] : yc[1];                                 \
      const float ysel = ykeep + dpp_get<0xB1>(ysend);                     \
      YB[(BUF) * 256 + kl * 16 + wave * 4 + rl] = ysel;                                                       \
    }
#define SC_YOUT(c, BUF)                                                                                       \
    {                                                                                                         \
      int row; SC_ROW((c) * SC_TOK + (tid >> 4), row);                                                        \
      Y[(size_t)row * 512 + h * 64 + rg * 16 + (tid & 15)] = (f16_t)(YB[(BUF) * 256 + tid] * 0.0625f);       \
    }
  constexpr int NCH = NKEY / SC_TOK;
  SC_LOAD(0, RA);
  SC_LOAD(1, RB);
  SC_STAGE(0, RA);
  __syncthreads();
  f32x2 S01 = {0.f, 0.f}, S23 = {0.f, 0.f};
  const int vidx = 320 + wave * 4 + rl;
  const bool bit3 = (kl & 8) != 0, bit2 = (kl & 4) != 0, bit1 = (kl & 2) != 0, bit0 = (kl & 1) != 0;
  __builtin_amdgcn_s_setprio(1);
  for (int c = 0; c < NCH; c += 2) {
    const bool more = (c + 2 < NCH);
    if (more) SC_LOAD(c + 2, RA);
    SC_CHUNK(0);
    SC_STAGE(1, RB);
    __syncthreads();
    SC_YOUT(c, 0);
    if (more) SC_LOAD(c + 3, RB);
    SC_CHUNK(1);
    if (more) SC_STAGE(0, RA);
    __syncthreads();
    SC_YOUT(c + 1, 1);
  }
  __builtin_amdgcn_s_setprio(0);
  __syncthreads();
#undef SC_ROW
#undef SC_LOAD
#undef SC_STAGE
#undef SC_STEP
#undef SC_CHUNK
#undef SC_YOUT
}

constexpr int AT_KB = 8192, AT_VB = 64 * 136;
template <bool SHIFT> DEVI void attn_body(const Params& p, int l, int idx, unsigned char* smem, float lam, float lam_init) {
  const int tid = get_tid(), lane = tid & 63, wave = tid >> 6, r32 = lane & 31, hh = lane >> 5;
  int b, h, qrow0, kt0, kt1;
  if (idx < 2048) { const int bh = idx >> 6, qb = idx & 63; b = bh >> 3; h = bh & 7; qrow0 = b * 8192 + qb * 128; kt0 = 0; kt1 = 132; }
  else { const int j = idx - 2048, bh = j >> 1, qb = j & 1; b = bh >> 3; h = bh & 7; qrow0 = TL + b * 256 + qb * 128; kt0 = 128; kt1 = 132; }
  const bf16_t* QK = (const bf16_t*)(p.ws + OFF_QK);
  const bf16_t* VT = (const bf16_t*)(p.ws + OFF_VT) + (size_t)(b * 8 + h) * 64 * NKEY;
  unsigned char* KB = smem;
  unsigned char* VB = smem + 2 * AT_KB;
  bf16x8 qf[2][2];
  {
    const bf16_t* qp = QK + (size_t)(qrow0 + wave * 32 + r32) * 1024 + h * 64 + hh * 8;
#pragma unroll
    for (int s = 0; s < 2; ++s)
#pragma unroll
      for (int ks = 0; ks < 2; ++ks) qf[s][ks] = *(const bf16x8*)(qp + s * 32 + ks * 16);
  }
  const int lkey = tid >> 2, lc0 = (tid & 3) * 2;
  u32x4 rk0, rk1, rv0, rv1;
#define AT_LOAD(kt)                                                                           \
  {                                                                                           \
    const int kx = (kt) * 64 + lkey;                                                          \
    const int krow = kx < 8192 ? b * 8192 + kx : TL + b * 256 + (kx - 8192);                  \
    const bf16_t* kp = QK + (size_t)krow * 1024 + 512 + h * 64 + lc0 * 8;                     \
    rk0 = *(const u32x4*)kp; rk1 = *(const u32x4*)(kp + 8);                                   \
    const bf16_t* vp = VT + (size_t)lkey * NKEY + (kt) * 64 + lc0 * 8;                        \
    rv0 = *(const u32x4*)vp; rv1 = *(const u32x4*)(vp + 8);                                   \
  }
#define AT_STORE(buf)                                                                         \
  {                                                                                           \
    unsigned char* kb = KB + (buf) * AT_KB + lkey * 128;                                      \
    const int sw = (lkey >> 1) & 7;                                                           \
    *(u32x4*)(kb + ((lc0 ^ sw) << 4)) = rk0;                                                  \
    *(u32x4*)(kb + (((lc0 + 1) ^ sw) << 4)) = rk1;                                            \
    unsigned char* vb = VB + (buf) * AT_VB + lkey * 136 + lc0 * 16;                           \
    u32x2 t;                                                                                  \
    t[0] = rv0[0]; t[1] = rv0[1]; *(u32x2*)(vb) = t;                                          \
    t[0] = rv0[2]; t[1] = rv0[3]; *(u32x2*)(vb + 8) = t;                                      \
    t[0] = rv1[0]; t[1] = rv1[1]; *(u32x2*)(vb + 16) = t;                                     \
    t[0] = rv1[2]; t[1] = rv1[3]; *(u32x2*)(vb + 24) = t;                                     \
  }
  f32x16 O[2][2];
#pragma unroll
  for (int s = 0; s < 2; ++s)
#pragma unroll
    for (int d = 0; d < 2; ++d)
#pragma unroll
      for (int e = 0; e < 16; ++e) O[s][d][e] = 0.f;
  float mref[2];
  f32x2 lacc[2];
  int need = 0;
  {
    const float* KM = (const float*)(p.ws + OFF_KM);
#pragma unroll
    for (int s = 0; s < 2; ++s) {
      float ss = 0.f;
#pragma unroll
      for (int ks = 0; ks < 2; ++ks)
#pragma unroll
        for (int j = 0; j < 8; ++j) { const float v = __uint_as_float(((unsigned)(unsigned short)qf[s][ks][j]) << 16); ss += v * v; }
      ss += shfl_xor_(ss, 32);
      mref[s] = sqrtf(ss * KM[(b * 8 + h) * 2 + s]);
      need |= (mref[s] > 96.0f) ? 1 : 0;
      lacc[s] = (f32x2){0.f, 0.f};
    }
  }
  (void)need;
  const f32x16 zero16 = {0.f, 0.f, 0.f, 0.f, 0.f, 0.f, 0.f, 0.f, 0.f, 0.f, 0.f, 0.f, 0.f, 0.f, 0.f, 0.f};
  AT_LOAD(kt0);
  AT_STORE(0);
  __syncthreads();
  for (int kt = kt0; kt < kt1; ++kt) {
    const int buf = (kt - kt0) & 1;
    const bool more = (kt + 1 < kt1);
    if (more) AT_LOAD(kt + 1);
    const unsigned char* kb = KB + buf * AT_KB;
    const unsigned char* vb = VB + buf * AT_VB;
#define AT_QK(S_, KB_, SC)                                                                                      \
    {                                                                                                           \
      const int key = (KB_) * 32 + r32;                                                                         \
      const bf16x8 kf0 = *(const bf16x8*)(kb + key * 128 + ((((S_) * 4 + hh) ^ ((key >> 1) & 7)) << 4));         \
      const bf16x8 kf1 = *(const bf16x8*)(kb + key * 128 + ((((S_) * 4 + 2 + hh) ^ ((key >> 1) & 7)) << 4));     \
      SC = __builtin_amdgcn_mfma_f32_32x32x16_bf16(kf0, qf[S_][0], zero16, 0, 0, 0);                            \
      SC = __builtin_amdgcn_mfma_f32_32x32x16_bf16(kf1, qf[S_][1], SC, 0, 0, 0);                                \
    }
#define AT_SPV(S_, KB_, SC)                                                                                     \
    {                                                                                                           \
      if (SHIFT) { _Pragma("unroll") for (int e = 0; e < 16; ++e) SC[e] -= mref[S_]; }                          \
      _Pragma("unroll") for (int e = 0; e < 16; ++e) SC[e] = __builtin_amdgcn_exp2f(SC[e]);                     \
      _Pragma("unroll") for (int e = 0; e < 8; ++e) lacc[S_] += (f32x2){SC[2 * e], SC[2 * e + 1]};              \
      _Pragma("unroll") for (int s2 = 0; s2 < 2; ++s2) {                                                        \
        u32x4 w;                                                                                                \
        w[0] = pk_bf16(SC[8 * s2 + 0], SC[8 * s2 + 1]); w[1] = pk_bf16(SC[8 * s2 + 2], SC[8 * s2 + 3]);         \
        w[2] = pk_bf16(SC[8 * s2 + 4], SC[8 * s2 + 5]); w[3] = pk_bf16(SC[8 * s2 + 6], SC[8 * s2 + 7]);         \
        const bf16x8 pf = __builtin_bit_cast(bf16x8, w);                                                        \
        _Pragma("unroll") for (int d = 0; d < 2; ++d) {                                                         \
          const unsigned char* vp = vb + (d * 32 + r32) * 136 + ((KB_) * 32 + 16 * s2 + 4 * hh) * 2;            \
          const u32x2 v0 = *(const u32x2*)vp, v1 = *(const u32x2*)(vp + 16);                                    \
          u32x4 vv; vv[0] = v0[0]; vv[1] = v0[1]; vv[2] = v1[0]; vv[3] = v1[1];                                 \
          const bf16x8 vf = __builtin_bit_cast(bf16x8, vv);                                                     \
          O[S_][d] = __builtin_amdgcn_mfma_f32_32x32x16_bf16(vf, pf, O[S_][d], 0, 0, 0);                        \
        }                                                                                                       \
      }                                                                                                         \
    }
    {
      f32x16 scA, scB;
      AT_QK(0, 0, scA);
      AT_QK(0, 1, scB);
      AT_SPV(0, 0, scA);
      AT_QK(1, 0, scA);
      AT_SPV(0, 1, scB);
      AT_QK(1, 1, scB);
      AT_SPV(1, 0, scA);
      AT_SPV(1, 1, scB);
    }
#undef AT_QK
#undef AT_SPV
    if (more) AT_STORE(buf ^ 1);
    __syncthreads();
  }
  float l1 = lacc[0].x + lacc[0].y, l2 = lacc[1].x + lacc[1].y;
  l1 += shfl_xor_(l1, 32); l2 += shfl_xor_(l2, 32);
  const float i1 = 1.0f / l1, i2 = lam / l2;
  float ss = 0.f;
#pragma unroll
  for (int d = 0; d < 2; ++d)
#pragma unroll
    for (int e = 0; e < 16; ++e) { const float o = O[0][d][e] * i1 - O[1][d][e] * i2; O[0][d][e] = o; ss += o * o; }
  ss += shfl_xor_(ss, 32);
  const float rstd = rsqrtf(ss * (1.0f / 64.0f) + 1e-5f) * (1.0f - lam_init);
  bf16_t* Oo = (bf16_t*)(p.ws + OFF_H) + (size_t)(qrow0 + wave * 32 + r32) * 1024 + 512 + h * 64;
  const float* sg = p.subln_g + l * 64;
#pragma unroll
  for (int d = 0; d < 2; ++d)
#pragma unroll
    for (int jq = 0; jq < 4; ++jq) {
      const int dv = d * 32 + 8 * jq + 4 * hh;
      const f32x4 g4 = *(const f32x4*)(sg + dv);
      u32x2 w;
      w[0] = pk_bf16(O[0][d][4 * jq + 0] * rstd * g4[0], O[0][d][4 * jq + 1] * rstd * g4[1]);
      w[1] = pk_bf16(O[0][d][4 * jq + 2] * rstd * g4[2], O[0][d][4 * jq + 3] * rstd * g4[3]);
      *(u32x2*)(Oo + dv) = w;
    }
#undef AT_LOAD
#undef AT_STORE
}

DEVI void attn_item(const Params& p, int l, int idx, unsigned char* smem, float lam, float lam_init) {
  const int tid = get_tid(), lane = tid & 63, wave = tid >> 6, r32 = lane & 31, hh = lane >> 5;
  int b, h, qrow0;
  if (idx < 2048) { const int bh = idx >> 6, qb = idx & 63; b = bh >> 3; h = bh & 7; qrow0 = b * 8192 + qb * 128; }
  else { const int j = idx - 2048, bh = j >> 1, qb = j & 1; b = bh >> 3; h = bh & 7; qrow0 = TL + b * 256 + qb * 128; }
  const bf16_t* qp = (const bf16_t*)(p.ws + OFF_QK) + (size_t)(qrow0 + wave * 32 + r32) * 1024 + h * 64 + hh * 8;
  const float* KM = (const float*)(p.ws + OFF_KM);
  int need = 0;
#pragma unroll
  for (int s = 0; s < 2; ++s) {
    float ss = 0.f;
#pragma unroll
    for (int ks = 0; ks < 2; ++ks) {
      const u32x4 v = *(const u32x4*)(qp + s * 32 + ks * 16);
#pragma unroll
      for (int j = 0; j < 4; ++j) { const float a = bflo(v[j]), c = bfhi(v[j]); ss += a * a + c * c; }
    }
    ss += shfl_xor_(ss, 32);
    need |= (sqrtf(ss * KM[(b * 8 + h) * 2 + s]) > 96.0f) ? 1 : 0;
  }
  need = __syncthreads_or(need);
  if (need) attn_body<true>(p, l, idx, smem, lam, lam_init);
  else attn_body<false>(p, l, idx, smem, lam, lam_init);
}

DEVI void kmax_job(const Params& p, unsigned char* smem) {
  const int tid = get_tid();
  const bf16_t* QK = (const bf16_t*)(p.ws + OFF_QK);
  float* red = (float*)smem;
  for (int item = blockIdx.x; item < NB * 16 * 8; item += gridDim.x) {
    const int bhs = item >> 3, chunk = item & 7, b = bhs >> 4, hs = bhs & 15;
    float mx = 0.f;
    for (int kx = chunk * 1056 + tid; kx < (chunk + 1) * 1056; kx += 256) {
      const int row = kx < 8192 ? b * 8192 + kx : TL + b * 256 + (kx - 8192);
      const bf16_t* kp = QK + (size_t)row * 1024 + 512 + hs * 32;
      float ss = 0.f;
#pragma unroll
      for (int c = 0; c < 4; ++c) {
        const u32x4 v = *(const u32x4*)(kp + c * 8);
#pragma unroll
        for (int j = 0; j < 4; ++j) { const float a = bflo(v[j]), bb = bfhi(v[j]); ss += a * a + bb * bb; }
      }
      mx = fmaxf(mx, ss);
    }
#pragma unroll
    for (int o = 32; o >= 1; o >>= 1) mx = fmaxf(mx, shfl_xor_(mx, o));
    if ((tid & 63) == 0) red[tid >> 6] = mx;
    __syncthreads();
    if (tid == 0) atomicMax((int*)(p.ws + OFF_KM) + bhs, __float_as_int(fmaxf(fmaxf(red[0], red[1]), fmaxf(red[2], red[3]))));
    __syncthreads();
  }
}

DEVI void phase_mixers(const Params& p, int l, unsigned char* smem, const Place& pl) {
  int* ctr = (int*)(p.ws + OFF_CTR) + l;
  int* s_item = (int*)(smem + 65536 - 16);
  const float lam_init = 0.8f - 0.6f * __expf(-0.3f * (float)l);
  float d1 = 0.f, d2 = 0.f;
  for (int i = 0; i < 32; ++i) { d1 += p.lam_q1[l * 32 + i] * p.lam_k1[l * 32 + i]; d2 += p.lam_q2[l * 32 + i] * p.lam_k2[l * 32 + i]; }
  const float lam = __expf(d1) - __expf(d2) + lam_init;
  const int nattn = 2048 + (l < DEPTH - 1 ? 64 : 0);
  int* ctr_s = ctr;
  int* ctr_a = ctr + 16;
  int mode = pl.scanpref ? 0 : 1;
  while (true) {
    if (get_tid() == 0) {
      int it = -1;
      if (mode == 0) { const int i = atomicAdd(ctr_s, 1); if (i < 256) it = i; else mode = 1; }
      if (it < 0 && mode == 1) { const int j = atomicAdd(ctr_a, 1); if (j < nattn) it = 256 + j; else mode = 2; }
      if (it < 0 && mode == 2) { const int i = atomicAdd(ctr_s, 1); if (i < 256) it = i; }
      s_item[0] = it; s_item[1] = mode;
    }
    __syncthreads();
    const int item = s_item[0];
    mode = s_item[1];
    __syncthreads();
    if (item < 0) break;
    if (item < 256) scan_item(p, l, item, smem);
    else attn_item(p, l, item - 256, smem, lam, lam_init);
  }
}

DEVI void finish(const Params& p, int l) {
  const int nrows = (l == DEPTH - 1) ? TL : NT;
  const f16_t* Y0 = (const f16_t*)(p.ws + OFF_Y);
  const f16_t* Y1 = Y0 + (size_t)NT * 512;
  const bf16_t* ZR = (const bf16_t*)(p.ws + OFF_ZR);
  const f16_t* GATE = (const f16_t*)(p.ws + OFF_GATE);
  bf16_t* Oo = (bf16_t*)(p.ws + OFF_H);
  const int total = nrows * 64;
  for (int idx = blockIdx.x * 256 + get_tid(); idx < total; idx += gridDim.x * 256) {
    const int row = idx >> 6, col = (idx & 63) * 8;
    const f16x8 y0 = __builtin_nontemporal_load((const f16x8*)(Y0 + (size_t)row * 512 + col)), y1 = __builtin_nontemporal_load((const f16x8*)(Y1 + (size_t)row * 512 + col));
    float y[8], s = 0.f;
#pragma unroll
    for (int j = 0; j < 8; ++j) { y[j] = ((float)y0[j] + (float)y1[j]) * 16.0f; s += y[j]; }
    s += shfl_xor_(s, 1); s += shfl_xor_(s, 2); s += shfl_xor_(s, 4);
    const float mu = s * (1.0f / 64.0f);
    float q = 0.f;
#pragma unroll
    for (int j = 0; j < 8; ++j) { y[j] -= mu; q += y[j] * y[j]; }
    q += shfl_xor_(q, 1); q += shfl_xor_(q, 2); q += shfl_xor_(q, 4);
    const float rstd = rsqrtf(q * (1.0f / 64.0f) + 64e-5f);
    const bf16_t* zr = ZR + (size_t)row * 1536 + col;
    const u32x4 ru = __builtin_nontemporal_load((const u32x4*)zr), ku = __builtin_nontemporal_load((const u32x4*)(zr + 512)), vu = __builtin_nontemporal_load((const u32x4*)(zr + 1024));
    float rf[8], kf[8], vf[8];
#pragma unroll
    for (int j = 0; j < 4; ++j) {
      rf[2 * j] = bflo(ru[j]); rf[2 * j + 1] = bfhi(ru[j]);
      kf[2 * j] = bflo(ku[j]); kf[2 * j + 1] = bfhi(ku[j]);
      vf[2 * j] = bflo(vu[j]); vf[2 * j + 1] = bfhi(vu[j]);
    }
    const float* rkp = p.r_k + l * 512 + col;
    const f32x4 rk0 = *(const f32x4*)rkp, rk1 = *(const f32x4*)(rkp + 4);
    float rk = 0.f;
#pragma unroll
    for (int j = 0; j < 4; ++j) rk += rf[j] * kf[j] * rk0[j] + rf[4 + j] * kf[4 + j] * rk1[j];
    rk += shfl_xor_(rk, 1); rk += shfl_xor_(rk, 2); rk += shfl_xor_(rk, 4);
    const f16x8 gt = __builtin_nontemporal_load((const f16x8*)(GATE + (size_t)row * 512 + col));
    const float* lg = p.lnx_g + l * 512 + col;
    const float* lb = p.lnx_b + l * 512 + col;
    const f32x4 g0 = *(const f32x4*)lg, g1 = *(const f32x4*)(lg + 4), b0 = *(const f32x4*)lb, b1 = *(const f32x4*)(lb + 4);
    float o[8];
#pragma unroll
    for (int j = 0; j < 8; ++j) {
      const float gg = j < 4 ? g0[j & 3] : g1[j & 3], bb = j < 4 ? b0[j & 3] : b1[j & 3];
      o[j] = ((y[j] * rstd * gg + bb) + rk * vf[j]) * (float)gt[j];
    }
    u32x4 w;
#pragma unroll
    for (int j = 0; j < 4; ++j) w[j] = pk_bf16(o[2 * j], o[2 * j + 1]);
    *(u32x4*)(Oo + (size_t)row * 1024 + col) = w;
  }
}

DEVI void run_phase(const Params& p, int ph, unsigned char* smem, const Place& pl) {
  if (ph == 0) { phase_setup(p, smem); return; }
  if (ph == 1) { rowpass(p, 0, 0); return; }
  const int l = (ph - 2) / 10, s = (ph - 2) % 10;
  const int nrows = (l == DEPTH - 1) ? TL : NT;
  bf16_t* W = (bf16_t*)(p.ws + OFF_W);
  GemmJob g;
  switch (s) {
    case 0:
      g.A = (const bf16_t*)(p.ws + OFF_H); g.lda = 1024; g.Bt = W; g.K = 1024; g.M = NT; g.N = INC; g.epi = EPI_G1;
      g.out = nullptr; g.ldc = 0; g.bias = nullptr;
      gemm_run<EPI_G1>(p, g, smem, pl);
      break;
    case 1:
      if (blockIdx.x == 0) { const int t_ = get_tid(); if (t_ < 64) ((int*)(p.ws + OFF_KM))[t_] = 0; }
      p1_shift(p, l);
      p1_rope(p);
      break;
    case 2: {
      const bf16_t* LW = (const bf16_t*)(p.ws + OFF_LW) + (size_t)l * 196608;
      const bf16_t* LA = (const bf16_t*)(p.ws + OFF_LA);
      kmax_job(p, smem);
      g.lda = 256; g.M = NT; g.N = 512; g.ldc = 512;
      for (int j = 0; j < 2; ++j) {
        g.A = LA; g.Bt = LW + j * 32768; g.K = 64; g.epi = EPI_EW; g.out = p.ws + OFF_EW + (size_t)j * SZ_T512x2; g.bias = p.w0 + (l * 2 + j) * 512;
        gemm_run<EPI_EW>(p, g, smem, pl);
      }
      for (int j = 0; j < 2; ++j) {
        g.A = LA + 64; g.Bt = LW + 65536 + j * 32768; g.K = 64; g.epi = EPI_SIG; g.out = p.ws + OFF_AA + (size_t)j * SZ_T512x2; g.bias = p.a0 + (l * 2 + j) * 512;
        gemm_run<EPI_SIG>(p, g, smem, pl);
      }
      g.A = LA + 128; g.Bt = LW + 131072; g.K = 128; g.epi = EPI_F16; g.out = p.ws + OFF_GATE; g.bias = nullptr;
      gemm_run<EPI_F16>(p, g, smem, pl);
      break;
    }
    case 3:
      phase_mixers(p, l, smem, pl);
      break;
    case 4:
      finish(p, l);
      convert_matrix(p.w_out + (size_t)l * 1024 * 1024, 1024, 1024, W, smem);
      convert_matrix(p.w_ff1 + (size_t)l * 1024 * 4096, 1024, 4096, W + 1024 * 1024, smem);
      convert_matrix(p.w_ff2 + (size_t)l * 4096 * 1024, 4096, 1024, W + 1024 * 1024 + 4096 * 1024, smem);
      break;
    case 5:
      g.A = (const bf16_t*)(p.ws + OFF_H); g.lda = 1024; g.Bt = W; g.K = 1024; g.M = nrows; g.N = 1024; g.epi = EPI_BF16;
      g.out = p.ws + OFF_F; g.ldc = 1024; g.bias = nullptr;
      gemm_run<EPI_BF16>(p, g, smem, pl);
      break;
    case 6:
      rowpass(p, 1, l);
      break;
    case 7:
      g.A = (const bf16_t*)(p.ws + OFF_H); g.lda = 1024; g.Bt = W + 1024 * 1024; g.K = 1024; g.M = nrows; g.N = 4096; g.epi = EPI_RELU2;
      g.out = p.ws + OFF_HID; g.ldc = 4096; g.bias = nullptr;
      gemm_run<EPI_RELU2>(p, g, smem, pl);
      break;
    case 8:
      g.A = (const bf16_t*)(p.ws + OFF_HID); g.lda = 4096; g.Bt = W + 1024 * 1024 + 4096 * 1024; g.K = 4096; g.M = nrows; g.N = 1024; g.epi = EPI_BF16;
      g.out = p.ws + OFF_F; g.ldc = 1024; g.bias = nullptr;
      gemm_run<EPI_BF16>(p, g, smem, pl);
      break;
    case 9:
      rowpass(p, 2, l);
      if (l + 1 < DEPTH) convert_matrix(p.w_in + (size_t)(l + 1) * 1024 * INC, 1024, INC, W, smem);
      break;
  }
}


#define XB_TMO      128
#define XB_XCNT(j)  (256  + 64 * (j))
#define XB_XSUB(j)  (1280 + 64 * (j))
#define XB_XGEN(j)  (2304 + 64 * (j))
#define XB_TOP      3328
#define XB_TOPGEN   3392
#define XB_PAR      192
#define XCD_BAR_WORDS 3456
#define XB_SPIN_CAP (1u << 22)
DEVI unsigned xb_ld(unsigned* p) { return __hip_atomic_load(p, __ATOMIC_RELAXED, __HIP_MEMORY_SCOPE_AGENT); }
DEVI unsigned xb_add(unsigned* p, unsigned v) { return __hip_atomic_fetch_add(p, v, __ATOMIC_RELAXED, __HIP_MEMORY_SCOPE_AGENT); }
DEVI unsigned xb_xcc_id() { return (unsigned)__builtin_amdgcn_s_getreg((3 << 11) | 20) & 0xFu; }
#define XB_SPIN(cond, bar) do { unsigned _sp = 0; while (cond) { __builtin_amdgcn_s_sleep(1); \
    if ((++_sp & 255u) == 0u) { if (xb_ld(&(bar)[XB_TMO])) break; if (_sp > XB_SPIN_CAP) { atomicAdd(&(bar)[XB_TMO], 1u); break; } } } } while (0)
DEVI void xcd_barrier(unsigned* bar, unsigned x, unsigned nloc, unsigned nx) {
  asm volatile("s_waitcnt vmcnt(0)" ::: "memory");
  __syncthreads();
  if (threadIdx.x == 0) {
    __builtin_amdgcn_s_waitcnt(0);
    const unsigned old = xb_add(&bar[XB_XSUB(x)], 1u);
    const unsigned gen = old / nloc;
    if (old + 1u == (gen + 1u) * nloc) {
      __builtin_amdgcn_fence(__ATOMIC_RELEASE, "agent");
      asm volatile("s_waitcnt vmcnt(0)" ::: "memory");
      const unsigned og = xb_add(&bar[XB_TOP], 1u);
      const unsigned tg = og / nx;
      if (og + 1u == (tg + 1u) * nx) xb_add(&bar[XB_TOPGEN], 1u);
      else XB_SPIN(xb_ld(&bar[XB_TOPGEN]) == tg, bar);
      __builtin_amdgcn_fence(__ATOMIC_ACQUIRE, "agent");
      xb_add(&bar[XB_XGEN(x)], 1u);
      asm volatile("s_waitcnt vmcnt(0)" ::: "memory");
    } else {
      XB_SPIN(xb_ld(&bar[XB_XGEN(x)]) == gen, bar);
      __builtin_amdgcn_fence(__ATOMIC_ACQUIRE, "agent");
      asm volatile("s_waitcnt vmcnt(0)" ::: "memory");
    }
  }
  __syncthreads();
}

__global__ void __launch_bounds__(256, 2) fwd_megakernel(Params p, int ph0, int ph1) {
  __shared__ __attribute__((aligned(16))) unsigned char smem[65536];
  cg::grid_group grid = cg::this_grid();
  unsigned* bar = (unsigned*)(p.ws + OFF_BAR);
  const unsigned xcc = xb_xcc_id();
  unsigned nloc = 1u, nx = 1u;
  const bool coop = (ph1 - ph0 > 1);
  Place pl; pl.xcc = (int)xcc; pl.rank = 0; pl.swz = 0; pl.scanpref = 1;
  const unsigned cu_par = ((unsigned)__builtin_amdgcn_s_getreg((15 << 11) | 4) >> 8) & 1u;
  if (coop) {
    if (threadIdx.x == 0 && cu_par) (void)xb_add(&bar[XB_PAR], 1u);
    if (threadIdx.x == 0) *(volatile unsigned*)smem = xb_add(&bar[XB_XCNT(xcc)], 1u);
    __syncthreads();
    pl.rank = __builtin_amdgcn_readfirstlane((int)*(volatile unsigned*)smem);
    __syncthreads();
  }
  for (int ph = ph0; ph < ph1; ++ph) {
    run_phase(p, ph, smem, pl);
    if (ph + 1 < ph1) {
      if (ph == ph0) {
        grid.sync();
        if (threadIdx.x == 0) {
          unsigned cnt = 0u, mine = 0u, ok = (gridDim.x == 512u) ? 1u : 0u;
#pragma unroll
          for (unsigned j = 0; j < 16; ++j) {
            const unsigned c = xb_ld(&bar[XB_XCNT(j)]);
            cnt += (c > 0u) ? 1u : 0u; mine = (j == xcc) ? c : mine;
            if (j < 8 ? (c != 64u) : (c != 0u)) ok = 0u;
          }
          nloc = mine > 0u ? mine : 1u; nx = cnt > 0u ? cnt : 1u;
          const unsigned n_odd = xb_ld(&bar[XB_PAR]), n_even = gridDim.x - n_odd;
          const unsigned scan_class = (n_even >= 256u) ? 0u : 1u;
          ((volatile unsigned*)smem)[0] = ok;
          ((volatile unsigned*)smem)[1] = (cu_par == scan_class) ? 1u : 0u;
        }
        __syncthreads();
        pl.swz = __builtin_amdgcn_readfirstlane((int)((volatile unsigned*)smem)[0]);
        pl.scanpref = __builtin_amdgcn_readfirstlane((int)((volatile unsigned*)smem)[1]);
        __syncthreads();
      } else {
        xcd_barrier(bar, xcc, nloc, nx);
      }
    }
  }
}

extern "C" void kernel_launch(void* const* d_in, const int* in_sizes, int n_in, void* d_out, int out_size,
                              void* d_ws, size_t ws_size, hipStream_t stream) {
  static int grid_blocks = 0;
  if (!grid_blocks) {
    int dev = 0, cus = 0, per_cu = 0;
    hipGetDevice(&dev);
    hipDeviceGetAttribute(&cus, hipDeviceAttributeMultiprocessorCount, dev);
    hipOccupancyMaxActiveBlocksPerMultiprocessor(&per_cu, fwd_megakernel, 256, 0);
    if (per_cu < 1) per_cu = 1;
    if (per_cu > 2) per_cu = 2;
    grid_blocks = cus * per_cu;
  }
  Params p{};
  const float** pp = (const float**)&p;
  for (int i = 0; i < 30; ++i) pp[i] = (const float*)d_in[i];
  p.out = (float*)d_out;
  p.ws = (unsigned char*)d_ws;
  if (ws_size < WS_END) { fprintf(stderr, "workspace too small: %zu < %zu\n", ws_size, (size_t)WS_END); return; }
  hipMemsetAsync(p.ws + OFF_BAR, 0, XCD_BAR_WORDS * 4, stream);
#if MULTI_LAUNCH
  for (int ph = 0; ph < NPH; ++ph) {
    hipLaunchKernelGGL(fwd_megakernel, dim3(grid_blocks), dim3(256), 0, stream, p, ph, ph + 1);
  }
#else
  int ph0 = 0, ph1 = NPH;
  void* args[] = {&p, &ph0, &ph1};
  hipError_t e = hipLaunchCooperativeKernel((void*)fwd_megakernel, dim3(grid_blocks), dim3(256), args, 0, stream);
  if (e != hipSuccess) fprintf(stderr, "cooperative launch failed: %s (grid %d)\n", hipGetErrorString(e), grid_blocks);
#endif
}
```
